# Optimizing an MI355X kernel written in HIP

```python
import jax, jax.numpy as jnp
from jax import lax
import numpy as np

D_MODEL = 1024
BATCH = 16
SEQ = 4096
DEPTH = 2

CTX_LEN = 256
GRID_W = 64
N_MOD = 9
D_FF = 2816
MIX_W = D_MODEL
GLA_HEADS = 4
GLA_DV = MIX_W // 2
GLA_DK = GLA_DV // 2
GLA_HEAD_V = GLA_DV // GLA_HEADS
GLA_HEAD_K = GLA_DK // GLA_HEADS
GLA_LOWRANK = 16
GATE_NORM = 16.0
GLA_CHUNK = 64
POOL_W = MIX_W // 4
POOL_WINDOWS = (2, 4, 8, 16)
POOL_GROUP = POOL_W // len(POOL_WINDOWS)
CONV_W = MIX_W // 4
CONV_K = 31
EPS = 1e-6
SPLIT_SIZES = (GLA_DK, GLA_DK, GLA_DV, GLA_DV, GLA_LOWRANK, GLA_LOWRANK, POOL_W, 2 * CONV_W)
D_IN = sum(SPLIT_SIZES)
SPLIT_IDX = [int(i) for i in np.cumsum(SPLIT_SIZES)[:-1]]

kernel_name = "hybrid_gla_pool_conv_macaron_dit"


def rms_norm(x, g):
    xf = x.astype(jnp.float32)
    y = xf * lax.rsqrt(jnp.mean(xf * xf, axis=-1, keepdims=True) + EPS)
    return (y * g.astype(jnp.float32)).astype(x.dtype)


def layer_norm(x, g, b):
    xf = x.astype(jnp.float32)
    mu = jnp.mean(xf, axis=-1, keepdims=True)
    var = jnp.mean(jnp.square(xf - mu), axis=-1, keepdims=True)
    y = (xf - mu) * lax.rsqrt(var + EPS) * g.astype(jnp.float32) + b.astype(jnp.float32)
    return y.astype(x.dtype)


def swiglu_ffn(h, w_up, w_down):
    a, b = jnp.split(h @ w_up, 2, axis=-1)
    return (jax.nn.silu(a) * b) @ w_down


def sub_in(h, gains, mods, i):
    return rms_norm(h, gains[2 * i]) * (1.0 + mods[3 * i + 1]) + mods[3 * i]


def sub_out(h, y, gains, mods, i, weight):
    return h + weight * mods[3 * i + 2] * rms_norm(y, gains[2 * i + 1])


def box_mean(x, axis, w):
    n = x.shape[axis]
    lo = w // 2
    hi = w - 1 - lo
    cs = jnp.cumsum(x.astype(jnp.float32), axis=axis)
    pad = [(0, 0)] * x.ndim
    pad[axis] = (1, 0)
    cs = jnp.pad(cs, pad)
    idx = jnp.arange(n)
    top = jnp.minimum(idx + hi + 1, n)
    bot = jnp.maximum(idx - lo, 0)
    s = jnp.take(cs, top, axis=axis) - jnp.take(cs, bot, axis=axis)
    shape = [1] * x.ndim
    shape[axis] = n
    cnt = (top - bot).astype(jnp.float32).reshape(shape)
    return (s / cnt).astype(x.dtype)


def pool_mixer(u, pool_w, pool_scale, grid):
    B, N, _ = u.shape
    outs = []
    for gi, w in enumerate(POOL_WINDOWS):
        ug = u[..., gi * POOL_GROUP:(gi + 1) * POOL_GROUP]
        if grid:
            rows = N // GRID_W
            u2 = ug.reshape(B, rows, GRID_W, POOL_GROUP)
            m = box_mean(box_mean(u2, 1, w), 2, w).reshape(B, N, POOL_GROUP)
        else:
            m = box_mean(ug, 1, w)
        outs.append((m - ug) @ pool_w[gi])
    return jnp.concatenate(outs, axis=-1) * pool_scale


def conv_module(u, dw, dw_b, ln_g, ln_b, pw, pw_b):
    a, gt = jnp.split(u, 2, axis=-1)
    h = a * jax.nn.sigmoid(gt)
    h = lax.conv_general_dilated(h, dw[:, None, :], window_strides=(1,),
                                 padding=[(CONV_K // 2, CONV_K // 2)],
                                 dimension_numbers=('NWC', 'WIO', 'NWC'),
                                 feature_group_count=CONV_W) + dw_b
    h = jax.nn.silu(layer_norm(h, ln_g, ln_b))
    return h @ pw + pw_b


def gla_chunk_scan(q, k, v, logg, s0):
    B, N, H, _ = q.shape
    dv = v.shape[-1]
    nc = N // GLA_CHUNK

    def to_chunks(t):
        return t.astype(jnp.float32).reshape(B, nc, GLA_CHUNK, H, t.shape[-1]).transpose(1, 0, 3, 2, 4)

    lower = jnp.tril(jnp.ones((GLA_CHUNK, GLA_CHUNK), dtype=bool))[:, :, None]

    def step(s, inp):
        qc, kc, vc, gc = inp
        b = jnp.cumsum(gc, axis=2)
        o_inter = jnp.einsum('bhik,bhkv->bhiv', qc * jnp.exp(b), s)
        diff = b[:, :, :, None, :] - b[:, :, None, :, :]
        decay = jnp.exp(jnp.where(lower, diff, -jnp.inf))
        att = jnp.einsum('bhijk,bhjk->bhij', qc[:, :, :, None, :] * decay, kc)
        o_intra = jnp.einsum('bhij,bhjv->bhiv', att, vc)
        b_last = b[:, :, -1:, :]
        s_new = jnp.exp(b_last[:, :, 0, :, None]) * s + jnp.einsum(
            'bhjk,bhjv->bhkv', kc * jnp.exp(b_last - b), vc)
        return s_new, o_inter + o_intra

    s_fin, o = lax.scan(step, s0, (to_chunks(q), to_chunks(k), to_chunks(v), to_chunks(logg)))
    o = o.transpose(1, 0, 3, 2, 4).reshape(B, N, H, dv)
    return o, s_fin


def gla_bidir(q, k, v, g_f, g_b, s_f, s_b):
    o_f, s_f_fin = gla_chunk_scan(q, k, v, g_f, s_f)
    flip = lambda t: jnp.flip(t, axis=1)
    o_b, s_b_fin = gla_chunk_scan(flip(q), flip(k), flip(v), flip(g_b), s_b)
    return o_f + flip(o_b), s_f_fin, s_b_fin


def gla_inputs(parts, w_gk2, b_gk):
    q, k, v, _, lr_f, lr_b = parts[:6]
    B, N, _ = q.shape
    heads_k = lambda t: t.reshape(B, N, GLA_HEADS, GLA_HEAD_K)

    def log_decay(lr, d):
        logit = (lr @ w_gk2[d] + b_gk[d]).astype(jnp.float32)
        return heads_k(jax.nn.log_sigmoid(logit) / GATE_NORM)

    return (heads_k(q) * GLA_HEAD_K ** -0.5, heads_k(k),
            v.reshape(B, N, GLA_HEADS, GLA_HEAD_V), log_decay(lr_f, 0), log_decay(lr_b, 1))


def mixer_output(parts, o_gla, grid, gla_norm_g, pool_w, pool_scale, conv_dw, conv_dw_b,
                 conv_ln_g, conv_ln_b, conv_pw, conv_pw_b, w_out):
    g = parts[3]
    B, N = g.shape[:2]
    y_gla = rms_norm(o_gla, gla_norm_g).reshape(B, N, GLA_DV).astype(g.dtype) * jax.nn.silu(g)
    y_pool = pool_mixer(parts[6], pool_w, pool_scale, grid)
    y_conv = conv_module(parts[7], conv_dw, conv_dw_b, conv_ln_g, conv_ln_b, conv_pw, conv_pw_b)
    return jnp.concatenate([y_gla, y_pool, y_conv], axis=-1) @ w_out


def token_mix(h_lat, h_ctx, w_in, w_gk2, b_gk, gla_norm_g, pool_w, pool_scale, conv_dw, conv_dw_b,
              conv_ln_g, conv_ln_b, conv_pw, conv_pw_b, w_out, need_ctx):
    parts_ctx = jnp.split(h_ctx @ w_in, SPLIT_IDX, axis=-1)
    parts_lat = jnp.split(h_lat @ w_in, SPLIT_IDX, axis=-1)
    B = h_ctx.shape[0]
    zero = jnp.zeros((B, GLA_HEADS, GLA_HEAD_K, GLA_HEAD_V), jnp.float32)
    o_ctx, s_f, s_b = gla_bidir(*gla_inputs(parts_ctx, w_gk2, b_gk), zero, zero)
    o_lat, _, _ = gla_bidir(*gla_inputs(parts_lat, w_gk2, b_gk), s_f, s_b)
    tail = (gla_norm_g, pool_w, pool_scale, conv_dw, conv_dw_b, conv_ln_g, conv_ln_b, conv_pw, conv_pw_b, w_out)
    y_lat = mixer_output(parts_lat, o_lat, True, *tail)
    y_ctx = mixer_output(parts_ctx, o_ctx, False, *tail) if need_ctx else None
    return y_lat, y_ctx


def setup_inputs(seed: int = 0) -> dict:
    key = jax.random.key(seed)
    ks = jax.random.split(key, 26)
    D = D_MODEL
    nrm = lambda k, shape, scale: jax.random.normal(k, shape, jnp.float32) * scale
    return {
        "x": nrm(ks[0], (BATCH, SEQ, D), 1.0),
        "c": nrm(ks[1], (BATCH, D), 1.0),
        "ctx": nrm(ks[2], (BATCH, CTX_LEN, D), 1.0),
        "c_ctx": nrm(ks[3], (D,), 1.0),
        "w_ada": nrm(ks[4], (DEPTH, D, N_MOD * D), 0.5 * D ** -0.5),
        "b_ada": nrm(ks[5], (DEPTH, N_MOD * D), 0.02),
        "norm_g": 1.0 + nrm(ks[6], (DEPTH, 6, D), 0.05),
        "ffn1_up": nrm(ks[7], (DEPTH, D, 2 * D_FF), D ** -0.5),
        "ffn1_down": nrm(ks[8], (DEPTH, D_FF, D), D_FF ** -0.5),
        "ffn2_up": nrm(ks[9], (DEPTH, D, 2 * D_FF), D ** -0.5),
        "ffn2_down": nrm(ks[10], (DEPTH, D_FF, D), D_FF ** -0.5),
        "w_in": nrm(ks[11], (DEPTH, D, D_IN), D ** -0.5),
        "w_gk2": nrm(ks[12], (DEPTH, 2, GLA_LOWRANK, GLA_DK), GLA_LOWRANK ** -0.5),
        "b_gk": nrm(ks[13], (DEPTH, 2, GLA_DK), 0.1),
        "gla_norm_g": 1.0 + nrm(ks[14], (DEPTH, GLA_HEAD_V), 0.05),
        "pool_w": nrm(ks[15], (DEPTH, len(POOL_WINDOWS), POOL_GROUP, POOL_GROUP), POOL_GROUP ** -0.5),
        "pool_scale": 1.0 + nrm(ks[16], (DEPTH, POOL_W), 0.05),
        "conv_dw": nrm(ks[17], (DEPTH, CONV_K, CONV_W), CONV_K ** -0.5),
        "conv_dw_b": nrm(ks[18], (DEPTH, CONV_W), 0.02),
        "conv_ln_g": 1.0 + nrm(ks[19], (DEPTH, CONV_W), 0.05),
        "conv_ln_b": nrm(ks[20], (DEPTH, CONV_W), 0.02),
        "conv_pw": nrm(ks[21], (DEPTH, CONV_W, CONV_W), CONV_W ** -0.5),
        "conv_pw_b": nrm(ks[22], (DEPTH, CONV_W), 0.02),
        "w_out": nrm(ks[23], (DEPTH, MIX_W, D), MIX_W ** -0.5),
    }


def reference(x, c, ctx, c_ctx, w_ada, b_ada, norm_g, ffn1_up, ffn1_down, ffn2_up, ffn2_down,
              w_in, w_gk2, b_gk, gla_norm_g, pool_w, pool_scale, conv_dw, conv_dw_b,
              conv_ln_g, conv_ln_b, conv_pw, conv_pw_b, w_out):
    for l in range(DEPTH):
        last = l == DEPTH - 1
        ml = jnp.split((jax.nn.silu(c) @ w_ada[l] + b_ada[l])[:, None, :], N_MOD, axis=-1)
        mc = jnp.split((jax.nn.silu(c_ctx) @ w_ada[l] + b_ada[l])[None, None, :], N_MOD, axis=-1)
        gains = norm_g[l]
        x = sub_out(x, swiglu_ffn(sub_in(x, gains, ml, 0), ffn1_up[l], ffn1_down[l]), gains, ml, 0, 0.5)
        ctx = sub_out(ctx, swiglu_ffn(sub_in(ctx, gains, mc, 0), ffn1_up[l], ffn1_down[l]), gains, mc, 0, 0.5)
        y_lat, y_ctx = token_mix(sub_in(x, gains, ml, 1), sub_in(ctx, gains, mc, 1),
                                 w_in[l], w_gk2[l], b_gk[l], gla_norm_g[l], pool_w[l], pool_scale[l],
                                 conv_dw[l], conv_dw_b[l], conv_ln_g[l], conv_ln_b[l], conv_pw[l],
                                 conv_pw_b[l], w_out[l], not last)
        x = sub_out(x, y_lat, gains, ml, 1, 1.0)
        x = sub_out(x, swiglu_ffn(sub_in(x, gains, ml, 2), ffn2_up[l], ffn2_down[l]), gains, ml, 2, 0.5)
        if not last:
            ctx = sub_out(ctx, y_ctx, gains, mc, 1, 1.0)
            ctx = sub_out(ctx, swiglu_ffn(sub_in(ctx, gains, mc, 2), ffn2_up[l], ffn2_down[l]), gains, mc, 2, 0.5)
    return x
```

```cpp
#include <hip/hip_runtime.h>
#include <hip/hip_cooperative_groups.h>
#include <cstdio>
#include <cstdint>
namespace cg = cooperative_groups;
namespace pg8 {
#define PG8_LAS __attribute__((address_space(3)))
typedef unsigned short bf16_t;
typedef short bf16x8 __attribute__((ext_vector_type(8)));
typedef float f32x4 __attribute__((ext_vector_type(4)));
typedef unsigned u32x4 __attribute__((ext_vector_type(4)));
constexpr int BM = 256, BK = 64, HALF = 128, HTB = HALF * BK * 2  , STAGE_BYTES = 8 * HTB, NXCD = 8, WGM = 4;

__host__ __device__ __forceinline__ int lds_byte(int r, int c) { const int st = (r >> 4) * 2 + (c >> 5), rr = r & 15, cc = c & 31, ob = rr * 64 + cc * 2; return st * 1024 + (ob ^ (((ob >> 9) & 1) << 5)); }
__host__ __device__ __forceinline__ void stage_rc(int b, int& R, int& C) { const int st = b / 1024, sb = b % 1024, swz = sb ^ (((sb >> 9) & 1) << 5); R = (st >> 1) * 16 + swz / 64; C = (st & 1) * 32 + (swz % 64) / 2; }
__host__ __device__ __forceinline__ int perm32(int rho) { const int n = rho >> 4, i = rho & 15; return 8 * (i >> 2) + 4 * n + (i & 3); }

struct Unit { int pm, pn; };
struct Gemm { const bf16_t* A; const bf16_t* Bt; int M, N, K; };

struct StaticOrder {
    int nM, nN, nwg, G, c;
    __host__ __device__ void init(int M, int N, int G_, int c_) { nM = M / BM; nN = N / BM; nwg = nM * nN; G = G_; c = c_; }
    __host__ __device__ bool next(int i, Unit& u) const {
        const long L = (long)i * G + c; if (L >= nwg) return false;
        int wgid = (int)L; { const int q = nwg / NXCD, r = nwg % NXCD, xcd = wgid % NXCD, off = wgid / NXCD; wgid = (xcd < r ? xcd * (q + 1) : r * (q + 1) + (xcd - r) * q) + off; }
        const int nig = WGM * nN, gid = wgid / nig, fm = gid * WGM, gsz = (nM - fm) < WGM ? (nM - fm) : WGM;
        u.pm = fm + ((wgid % nig) % gsz); u.pn = (wgid % nig) / gsz; return true;
    }
    __device__ __forceinline__ void a_ready(const Unit&) const {}
    __device__ __forceinline__ void done(const Unit&) const {}
};
__device__ __forceinline__ unsigned cvt_pk_bf16(float lo, float hi) { unsigned r; asm volatile("v_cvt_pk_bf16_f32 %0, %1, %2" : "=v"(r) : "v"(lo), "v"(hi)); return r; }
__device__ __forceinline__ float silu_f(float x) { return x * __builtin_amdgcn_rcpf(1.0f + __expf(-x)); }
struct EpiF32 {
    static constexpr bool PERM = false, AFTER_DRAIN = false;
    float* C; int ldc; const float* bias;
    __device__ __forceinline__ void operator()(const f32x4 (&acc)[2][2][4][2], const Unit& u, int wr, int wc, int fr, int fq) const {
        const int row0 = u.pm * BM + wr * 64 + fr, col0 = u.pn * BM + wc * 32 + 4 * fq;
        f32x4 bv[2][2];
#pragma unroll
        for (int bj = 0; bj < 2; ++bj)
#pragma unroll
            for (int n = 0; n < 2; ++n) bv[bj][n] = bias ? *(const f32x4*)(bias + col0 + bj * HALF + n * 16) : (f32x4){0.f, 0.f, 0.f, 0.f};
#pragma unroll
        for (int ai = 0; ai < 2; ++ai)
#pragma unroll
            for (int m = 0; m < 4; ++m) { float* rowp = C + (size_t)(row0 + ai * HALF + m * 16) * ldc + col0;
#pragma unroll
                for (int bj = 0; bj < 2; ++bj)
#pragma unroll
                    for (int n = 0; n < 2; ++n) *(f32x4*)(rowp + bj * HALF + n * 16) = acc[ai][bj][m][n] + bv[bj][n]; }
    }
};
struct EpiBf16 {
    static constexpr bool PERM = true, AFTER_DRAIN = false;
    bf16_t* O; int ldc; int swiglu; const float* bias;
    __device__ __forceinline__ void operator()(const f32x4 (&acc)[2][2][4][2], const Unit& u, int wr, int wc, int fr, int fq) const {
        const int row0 = u.pm * BM + wr * 64 + fr;
        if (swiglu) {
            const int col0 = u.pn * HALF + wc * 32 + 8 * fq;
#pragma unroll
            for (int ai = 0; ai < 2; ++ai)
#pragma unroll
                for (int m = 0; m < 4; ++m) { bf16_t* rowp = O + (size_t)(row0 + ai * HALF + m * 16) * ldc + col0;
                    const f32x4 a0 = acc[ai][0][m][0], a1 = acc[ai][0][m][1], b0 = acc[ai][1][m][0], b1 = acc[ai][1][m][1];
                    u32x4 w; w.x = cvt_pk_bf16(silu_f(a0[0]) * b0[0], silu_f(a0[1]) * b0[1]); w.y = cvt_pk_bf16(silu_f(a0[2]) * b0[2], silu_f(a0[3]) * b0[3]);
                    w.z = cvt_pk_bf16(silu_f(a1[0]) * b1[0], silu_f(a1[1]) * b1[1]); w.w = cvt_pk_bf16(silu_f(a1[2]) * b1[2], silu_f(a1[3]) * b1[3]);
                    *(u32x4*)rowp = w; }
        } else {
            const int col0 = u.pn * BM + wc * 32 + 8 * fq;
            f32x4 bv[2][2];
#pragma unroll
            for (int bj = 0; bj < 2; ++bj)
#pragma unroll
                for (int n = 0; n < 2; ++n) bv[bj][n] = bias ? *(const f32x4*)(bias + col0 + bj * HALF + 4 * n) : (f32x4){0.f, 0.f, 0.f, 0.f};
#pragma unroll
            for (int ai = 0; ai < 2; ++ai)
#pragma unroll
                for (int m = 0; m < 4; ++m) { bf16_t* rowp = O + (size_t)(row0 + ai * HALF + m * 16) * ldc + col0;
#pragma unroll
                    for (int bj = 0; bj < 2; ++bj) { const f32x4 v0 = acc[ai][bj][m][0] + bv[bj][0], v1 = acc[ai][bj][m][1] + bv[bj][1];
                        u32x4 w; w.x = cvt_pk_bf16(v0[0], v0[1]); w.y = cvt_pk_bf16(v0[2], v0[3]); w.z = cvt_pk_bf16(v1[0], v1[1]); w.w = cvt_pk_bf16(v1[2], v1[3]);
                        *(u32x4*)(rowp + bj * HALF) = w; } }
        }
    }
};

template <class Epi, class Sched, bool ALIGN_EPI = false, bool SP2 = false>
__device__ __forceinline__ void gemm_phase(PG8_LAS unsigned char* lds, const Gemm g, const Sched& S, const Epi& E) {
    int tid_l = threadIdx.x; asm volatile("" : "+v"(tid_l));
    const int tid = tid_l, wid = __builtin_amdgcn_readfirstlane(tid >> 6), lane = tid & 63, wr = wid >> 2, wc = wid & 3, fr = lane & 15, fq = lane >> 4;
    const int K = g.K, nt = K / BK;
    unsigned voffA[2], voffB[2];
#pragma unroll
    for (int i = 0; i < 2; ++i) { int R, C; stage_rc(tid * 16 + i * 8192, R, C); const int Rb = Epi::PERM ? ((R & ~31) + perm32(R & 31)) : R;
        voffA[i] = (unsigned)(R * K + C) * 2u; voffB[i] = (unsigned)(Rb * K + C) * 2u; }
    const size_t kstep = (size_t)(BK * 2);
    const size_t hstep = (size_t)HALF * K * 2;
    const size_t tstep = 2 * hstep;
    const unsigned ldsw = (unsigned)wid * 1024u;
    const int aoff = lds_byte(wr * 64 + fr, fq * 8), boff = lds_byte(wc * 32 + fr, fq * 8);
#define PG8_SA(b, h) (((b) * 2 + (h)) * HTB)
#define PG8_SB(b, h) ((4 + (b) * 2 + (h)) * HTB)
#define PG8_STAGE(bufoff, gbase, voff) do { _Pragma("unroll") for (int _i = 0; _i < 2; ++_i) \
        __builtin_amdgcn_global_load_lds((const unsigned*)((const char*)(gbase) + (voff)[_i]), (PG8_LAS unsigned*)(lds + (bufoff) + ldsw + _i * 8192), 16, 0, 0); } while (0)
#define PG8_LDA(dst, b, h) do { _Pragma("unroll") for (int m = 0; m < 4; ++m) _Pragma("unroll") for (int k = 0; k < 2; ++k) dst[m][k] = *(const PG8_LAS bf16x8*)(lds + PG8_SA(b, h) + aoff + m * 2048 + k * 1024); } while (0)
#define PG8_LDB(dst, b, h) do { _Pragma("unroll") for (int n = 0; n < 2; ++n) _Pragma("unroll") for (int k = 0; k < 2; ++k) dst[n][k] = *(const PG8_LAS bf16x8*)(lds + PG8_SB(b, h) + boff + n * 2048 + k * 1024); } while (0)
#define PG8_MMA(ai, bj, At, Bt) do { __builtin_amdgcn_s_setprio(1); _Pragma("unroll") for (int m = 0; m < 4; ++m) _Pragma("unroll") for (int n = 0; n < 2; ++n) _Pragma("unroll") for (int k = 0; k < 2; ++k) \
        acc[ai][bj][m][n] = __builtin_amdgcn_mfma_f32_16x16x32_bf16(Bt[n][k], At[m][k], acc[ai][bj][m][n], 0, 0, 0); __builtin_amdgcn_s_setprio(0); } while (0)
#define PG8_WAIT_V(n) asm volatile("s_waitcnt vmcnt(" #n ")" ::: "memory")
#define PG8_WAIT_L(n) asm volatile("s_waitcnt lgkmcnt(" #n ")" ::: "memory")
#define PG8_BAR __builtin_amdgcn_s_barrier()
#define PG8_SCHED __builtin_amdgcn_sched_barrier(0)
    Unit cur, nxt; int ui = 0;
    if (!S.next(0, cur)) return;
    f32x4 acc[2][2][4][2];
#pragma unroll
    for (int a = 0; a < 2; ++a)
#pragma unroll
        for (int b = 0; b < 2; ++b)
#pragma unroll
            for (int m = 0; m < 4; ++m)
#pragma unroll
                for (int n = 0; n < 2; ++n) acc[a][b][m][n] = (f32x4){0.f, 0.f, 0.f, 0.f};
    bf16x8 At[4][2], B0[2][2], B1[2][2];
    const char* cA = (const char*)g.A + (size_t)cur.pm * tstep; const char* cB = (const char*)g.Bt + (size_t)cur.pn * tstep;
    S.a_ready(cur);
    if constexpr (SP2) {
        PG8_STAGE(PG8_SB(0, 0), cB, voffB); PG8_STAGE(PG8_SB(0, 1), cB + hstep, voffB); PG8_STAGE(PG8_SA(0, 0), cA, voffA); PG8_STAGE(PG8_SA(0, 1), cA + hstep, voffA);
        if (wr == 1) PG8_BAR;
        PG8_WAIT_V(2); PG8_BAR;
        PG8_STAGE(PG8_SB(1, 0), cB + kstep, voffB); PG8_STAGE(PG8_SA(1, 0), cA + kstep, voffA); PG8_STAGE(PG8_SB(1, 1), cB + hstep + kstep, voffB);
        PG8_WAIT_V(6); PG8_BAR;
    } else {
        PG8_STAGE(PG8_SB(0, 0), cB, voffB); PG8_STAGE(PG8_SA(0, 0), cA, voffA); PG8_STAGE(PG8_SB(0, 1), cB + hstep, voffB); PG8_STAGE(PG8_SA(0, 1), cA + hstep, voffA);
        if (wr == 1) PG8_BAR;
        PG8_WAIT_V(4); PG8_BAR;
        PG8_STAGE(PG8_SB(1, 0), cB + kstep, voffB); PG8_STAGE(PG8_SA(1, 0), cA + kstep, voffA); PG8_STAGE(PG8_SB(1, 1), cB + hstep + kstep, voffB);
        PG8_WAIT_V(6); PG8_BAR;
    }
    for (;;) {
        const bool has_next = S.next(ui + 1, nxt);
        const char* nA = has_next ? (const char*)g.A + (size_t)nxt.pm * tstep : cA; const char* nB = has_next ? (const char*)g.Bt + (size_t)nxt.pn * tstep : cB;
        for (int t = 0; t < nt; t += 2) {
            const bool last = (t == nt - 2);
            const char* a1 = cA + (size_t)(t + 1) * kstep;
            const char* a2 = last ? nA : cA + (size_t)(t + 2) * kstep; const char* b2 = last ? nB : cB + (size_t)(t + 2) * kstep;
            const char* a3 = a2 + kstep; const char* b3 = b2 + kstep;
            if (last && has_next) S.a_ready(nxt);
            if constexpr (SP2) {
            PG8_LDB(B0, 0, 0); PG8_LDB(B1, 0, 1); PG8_SCHED; PG8_LDA(At, 0, 0); PG8_STAGE(PG8_SA(1, 1), a1 + hstep, voffA);
            PG8_WAIT_V(8); PG8_WAIT_L(0); PG8_BAR; PG8_MMA(0, 0, At, B0); PG8_MMA(0, 1, At, B1); PG8_BAR; PG8_SCHED;
            PG8_LDA(At, 0, 1); PG8_STAGE(PG8_SB(0, 0), b2, voffB); PG8_STAGE(PG8_SB(0, 1), b2 + hstep, voffB); PG8_STAGE(PG8_SA(0, 0), a2, voffA);
            PG8_WAIT_V(8); PG8_WAIT_L(0); PG8_BAR; PG8_MMA(1, 0, At, B0); PG8_MMA(1, 1, At, B1); PG8_BAR; PG8_SCHED;
            PG8_LDB(B0, 1, 0); PG8_LDB(B1, 1, 1); PG8_SCHED; PG8_LDA(At, 1, 0); PG8_STAGE(PG8_SA(0, 1), a2 + hstep, voffA);
            PG8_WAIT_V(8); PG8_WAIT_L(0); PG8_BAR; PG8_MMA(0, 0, At, B0); PG8_MMA(0, 1, At, B1); PG8_BAR; PG8_SCHED;
            PG8_LDA(At, 1, 1); PG8_STAGE(PG8_SB(1, 0), b3, voffB); PG8_STAGE(PG8_SB(1, 1), b3 + hstep, voffB); PG8_STAGE(PG8_SA(1, 0), a3, voffA);
            PG8_WAIT_V(8); PG8_WAIT_L(0); PG8_BAR; PG8_MMA(1, 0, At, B0); PG8_MMA(1, 1, At, B1); PG8_BAR; PG8_SCHED;
            } else {
            PG8_LDB(B0, 0, 0); PG8_SCHED; PG8_LDA(At, 0, 0); PG8_STAGE(PG8_SA(1, 1), a1 + hstep, voffA);
            PG8_WAIT_L(8); PG8_BAR; PG8_WAIT_L(0); PG8_MMA(0, 0, At, B0); PG8_BAR; PG8_SCHED;
            PG8_LDB(B1, 0, 1); PG8_STAGE(PG8_SB(0, 0), b2, voffB);
            PG8_BAR; PG8_WAIT_L(0); PG8_MMA(0, 1, At, B1); PG8_BAR;
            PG8_LDA(At, 0, 1); PG8_STAGE(PG8_SA(0, 0), a2, voffA);
            PG8_BAR; PG8_WAIT_L(0); PG8_MMA(1, 0, At, B0); PG8_BAR; PG8_SCHED;
            PG8_STAGE(PG8_SB(0, 1), b2 + hstep, voffB);
            PG8_WAIT_V(6); PG8_BAR; PG8_MMA(1, 1, At, B1); PG8_BAR;
            PG8_LDB(B0, 1, 0); PG8_SCHED; PG8_LDA(At, 1, 0); PG8_STAGE(PG8_SA(0, 1), a2 + hstep, voffA);
            PG8_WAIT_L(8); PG8_BAR; PG8_WAIT_L(0); PG8_MMA(0, 0, At, B0); PG8_BAR; PG8_SCHED;
            PG8_LDB(B1, 1, 1); PG8_STAGE(PG8_SB(1, 0), b3, voffB);
            PG8_BAR; PG8_WAIT_L(0); PG8_MMA(0, 1, At, B1); PG8_BAR;
            PG8_LDA(At, 1, 1); PG8_STAGE(PG8_SA(1, 0), a3, voffA);
            PG8_BAR; PG8_WAIT_L(0); PG8_MMA(1, 0, At, B0); PG8_BAR; PG8_SCHED;
            PG8_STAGE(PG8_SB(1, 1), b3 + hstep, voffB);
            PG8_WAIT_V(6); PG8_BAR; PG8_MMA(1, 1, At, B1); PG8_BAR;
            }
        }
        if constexpr (ALIGN_EPI) { if (wr == 0) PG8_BAR; }
        if constexpr (!Epi::AFTER_DRAIN) { E(acc, cur, wr, wc, fr, fq); S.done(cur); }
        if (!has_next) break;
#pragma unroll
        for (int a = 0; a < 2; ++a)
#pragma unroll
            for (int b = 0; b < 2; ++b)
#pragma unroll
                for (int m = 0; m < 4; ++m)
#pragma unroll
                    for (int n = 0; n < 2; ++n) acc[a][b][m][n] = (f32x4){0.f, 0.f, 0.f, 0.f};
        cur = nxt; cA = nA; cB = nB; ++ui;
        if constexpr (ALIGN_EPI) { if (wr == 1) PG8_BAR; }
    }
    PG8_WAIT_V(0);
    if constexpr (!ALIGN_EPI) { if (wr == 0) PG8_BAR; }
    PG8_BAR;
    if constexpr (Epi::AFTER_DRAIN) { E.fused(acc, cur, wr, wc, fr, fq, lds, wid, lane); S.done(cur); }
#undef PG8_SA
#undef PG8_SB
#undef PG8_STAGE
#undef PG8_LDA
#undef PG8_LDB
#undef PG8_MMA
#undef PG8_WAIT_V
#undef PG8_WAIT_L
#undef PG8_BAR
#undef PG8_SCHED
}
}

constexpr int D = 1024, NBATCH = 16, SEQ = 4096, CTXL = 256, TL = NBATCH * SEQ, TC = NBATCH * CTXL, TT_ROWS = TL + TC;
constexpr int DFF = 2816, NUP = 2 * DFF, DIN = 2336, NIN = 2560, NMOD = 9;
constexpr int NCHUNK = TT_ROWS / 64;
constexpr int PSTR = NIN;
constexpr int PC_Q = 0, PC_K = 256, PC_V = 512, PC_G = 1024, PC_POOL = 1536, PC_CA = 1792, PC_CG = 2048, PC_LR = 2304;
constexpr float EPS = 1e-6f;
constexpr int NWAVES = 8, NTHREADS = 512;
constexpr int LDS_BYTES = 163840;

constexpr size_t MiB = 1u << 20;
constexpr size_t WS_MODS = 0;
constexpr size_t WS_BOUT = WS_MODS + (size_t)1536 * 1024;
constexpr size_t WS_BAR = (size_t)1792 * 1024, BAR_BYTES = 16384;
constexpr size_t WS_W = 2 * MiB, W_LAYER = 40 * MiB;
constexpr size_t WO_UP1 = 0, WO_DN1 = 11 * MiB, WO_UP2 = 33 * MiB / 2, WO_DN2 = 55 * MiB / 2, WO_IN = 33 * MiB, WO_OUT = 38 * MiB;
constexpr size_t WS_CTXR = 82 * MiB;
constexpr size_t WS_H = 98 * MiB;
constexpr size_t WS_ACT = 234 * MiB;
constexpr size_t WS_Y = 608 * MiB;
constexpr size_t WS_DC = 880 * MiB;
constexpr size_t WS_XR = 884 * MiB;
constexpr size_t WS_END = 1020 * MiB;

typedef unsigned short bf16;
typedef float f32x4 __attribute__((ext_vector_type(4)));
typedef short bf16x8 __attribute__((ext_vector_type(8)));
typedef unsigned u32x4v __attribute__((ext_vector_type(4)));
typedef unsigned u32x2v __attribute__((ext_vector_type(2)));

typedef __bf16 bf16x2n __attribute__((ext_vector_type(2)));
typedef float f32x2n __attribute__((ext_vector_type(2)));
__device__ __forceinline__ unsigned f2bf(float f) { return (unsigned)__builtin_bit_cast(unsigned short, (__bf16)f); }
__device__ __forceinline__ unsigned pk2(float lo, float hi) { const f32x2n v = {lo, hi}; return __builtin_bit_cast(unsigned, __builtin_convertvector(v, bf16x2n)); }
__device__ __forceinline__ float bflo(unsigned w) { return __builtin_bit_cast(float, w << 16); }
__device__ __forceinline__ float bfhi(unsigned w) { return __builtin_bit_cast(float, w & 0xffff0000u); }
__device__ __forceinline__ float bf2f(bf16 b) { return __builtin_bit_cast(float, (unsigned)b << 16); }
__device__ __forceinline__ float wave_sum(float v) {
#pragma unroll
    for (int o = 1; o < 64; o <<= 1) v += __shfl_xor(v, o);
    return v;
}
__device__ __forceinline__ float sigmoid_f(float x) { return __builtin_amdgcn_rcpf(1.0f + __expf(-x)); }
__device__ __forceinline__ float silu(float x) { return x * sigmoid_f(x); }
__device__ __forceinline__ float logsigmoid_f(float x) { return fminf(x, 0.f) - __logf(1.0f + __expf(-fabsf(x))); }
__device__ __forceinline__ void unpack8(const u32x4v r, float (&f)[8]) { f[0] = bflo(r.x); f[1] = bfhi(r.x); f[2] = bflo(r.y); f[3] = bfhi(r.y); f[4] = bflo(r.z); f[5] = bfhi(r.z); f[6] = bflo(r.w); f[7] = bfhi(r.w); }

struct KArgs { const float* in[24]; float* out; unsigned char* ws; };
enum { I_X = 0, I_C, I_CTX, I_CCTX, I_WADA, I_BADA, I_NORMG, I_F1UP, I_F1DN, I_F2UP, I_F2DN, I_WIN, I_WGK2, I_BGK, I_GLAG, I_POOLW, I_POOLS, I_CDW, I_CDWB, I_CLNG, I_CLNB, I_CPW, I_CPWB, I_WOUT };

#define LAS __attribute__((address_space(3)))
#define XB_TMO      128
#define XB_XCNT(j)  (256  + 64 * (j))
#define XB_XSUB(j)  (1280 + 64 * (j))
#define XB_XGEN(j)  (2304 + 64 * (j))
#define XB_TOP      3328
#define XB_TOPGEN   3392
#define XCD_BAR_WORDS 3456
#define XB_SPIN_CAP (1u << 18)

__device__ __forceinline__ unsigned xb_ld(unsigned* p)              { return __hip_atomic_load(p, __ATOMIC_RELAXED, __HIP_MEMORY_SCOPE_AGENT); }
__device__ __forceinline__ unsigned xb_add(unsigned* p, unsigned v) { return __hip_atomic_fetch_add(p, v, __ATOMIC_RELAXED, __HIP_MEMORY_SCOPE_AGENT); }
__device__ __forceinline__ unsigned xb_xcc_id() { return (unsigned)__builtin_amdgcn_s_getreg((3 << 11) | 20) & 0xFu; }
#define XB_SPIN(cond, bar) do { unsigned _sp = 0; while (cond) { __builtin_amdgcn_s_sleep(1); \
    if ((++_sp & 255u) == 0u) { if (xb_ld(&(bar)[XB_TMO])) break; if (_sp > XB_SPIN_CAP) { atomicAdd(&(bar)[XB_TMO], 1u); break; } } } } while (0)

struct XcdBarrier {
    unsigned* bar; unsigned x;
    volatile LAS unsigned* st;
};

__device__ __forceinline__ XcdBarrier xcd_barrier_post(unsigned* bar, volatile LAS unsigned* st) {
    XcdBarrier b; b.bar = bar; b.x = xb_xcc_id(); b.st = st;
    if (threadIdx.x == 0) (void)xb_add(&bar[XB_XCNT(b.x)], 1u);
    return b;
}
__device__ __forceinline__ void xcd_barrier_complete(unsigned* bar, unsigned x, unsigned& nloc, unsigned& nx) {
    const unsigned G = gridDim.x * gridDim.y * gridDim.z;
    unsigned sum, cnt, mine, sp = 0u;
    for (;;) {
        sum = 0u; cnt = 0u; mine = 0u;
#pragma unroll
        for (unsigned j = 0; j < 16; ++j) { const unsigned c = xb_ld(&bar[XB_XCNT(j)]); sum += c; cnt += (c > 0u) ? 1u : 0u; mine = (j == x) ? c : mine; }
        if (sum == G) break;
        __builtin_amdgcn_s_sleep(1);
        if ((++sp & 255u) == 0u) { if (xb_ld(&bar[XB_TMO])) break; if (sp > XB_SPIN_CAP) { atomicAdd(&bar[XB_TMO], 1u); break; } }
    }
    nloc = mine > 0u ? mine : 1u; nx = cnt > 0u ? cnt : 1u;
}

__device__ __forceinline__ void xcd_barrier(const XcdBarrier& b) {
    asm volatile("s_waitcnt vmcnt(0)" ::: "memory");
    __syncthreads();
    if (threadIdx.x == 0) {
        unsigned* bar = b.bar;
        __builtin_amdgcn_s_waitcnt(0);
        unsigned nloc = b.st[0], nx = b.st[1];
        if (nloc == 0u) { xcd_barrier_complete(bar, b.x, nloc, nx); b.st[0] = nloc; b.st[1] = nx; }
        const unsigned old = xb_add(&bar[XB_XSUB(b.x)], 1u);
        const unsigned gen = old / nloc;
        if (old + 1u == (gen + 1u) * nloc) {
            __builtin_amdgcn_fence(__ATOMIC_RELEASE, "agent");
            asm volatile("s_waitcnt vmcnt(0)" ::: "memory");
            const unsigned og = xb_add(&bar[XB_TOP], 1u);
            const unsigned tg = og / nx;
            if (og + 1u == (tg + 1u) * nx) xb_add(&bar[XB_TOPGEN], 1u);
            else XB_SPIN(xb_ld(&bar[XB_TOPGEN]) == tg, bar);
            __builtin_amdgcn_fence(__ATOMIC_ACQUIRE, "agent");
            xb_add(&bar[XB_XGEN(b.x)], 1u);
            asm volatile("s_waitcnt vmcnt(0)" ::: "memory");
        } else {
            XB_SPIN(xb_ld(&bar[XB_XGEN(b.x)]) == gen, bar);
            __builtin_amdgcn_fence(__ATOMIC_ACQUIRE, "agent");
            asm volatile("s_waitcnt vmcnt(0)" ::: "memory");
        }
    }
    __syncthreads();
}

typedef const KArgs __attribute__((address_space(4)))* KArgsP;
__device__ __forceinline__ KArgs load_args() {
    KArgsP p = (KArgsP)__builtin_amdgcn_kernarg_segment_ptr(); asm volatile("" : "+s"(p));
    KArgs a;
#pragma unroll
    for (int i = 0; i < 24; ++i) a.in[i] = p->in[i];
    a.out = p->out; a.ws = p->ws; return a;
}
__device__ __forceinline__ int opaque_tid() { int t = threadIdx.x; asm volatile("" : "+v"(t)); return t; }
#define PHASE_LOCALS const KArgs a = load_args(); const int tid = opaque_tid(), lane = tid & 63, wave = __builtin_amdgcn_readfirstlane(tid >> 6); (void)lane; (void)wave;

__device__ __forceinline__ void tr_item(const float* W, int ldw, int col0, bf16* WT, int ldt, int drow0, int k0, float* scr, int lane, bool zero) {
#pragma unroll 8
    for (int i = 0; i < 32; ++i) { const int kk = 2 * i + (lane >> 5); scr[kk * 33 + (lane & 31)] = zero ? 0.f : W[(size_t)(k0 + kk) * ldw + col0 + (lane & 31)]; }
    asm volatile("s_waitcnt lgkmcnt(0)" ::: "memory");
    const int c = lane & 7;
#pragma unroll
    for (int j = 0; j < 4; ++j) { const int n = (lane >> 3) + 8 * j; const float* s = scr + (8 * c) * 33 + n;
        u32x4v o; o.x = pk2(s[0 * 33], s[1 * 33]); o.y = pk2(s[2 * 33], s[3 * 33]); o.z = pk2(s[4 * 33], s[5 * 33]); o.w = pk2(s[6 * 33], s[7 * 33]);
        *(u32x4v*)(WT + (size_t)(drow0 + n) * ldt + k0 + 8 * c) = o; }
    asm volatile("s_waitcnt lgkmcnt(0)" ::: "memory");
}

__device__ __forceinline__ void prep_phase(const KArgs& a, unsigned char* lds, int tid, int lane, int wave, int G) {
    float* scr = (float*)(lds + wave * 16384);
    const int gw = blockIdx.x * NWAVES + wave, NGW = G * NWAVES;
    constexpr int I_UP = 16 * 176, I_DN = 44 * 32, I_IN = 16 * 80, I_OT = 8 * 32, I_LAYER = 2 * I_UP + 2 * I_DN + I_IN + I_OT;
    for (int it = gw; it < 2 * I_LAYER; it += NGW) {
        const int l = it / I_LAYER; int r = it % I_LAYER;
        unsigned char* wl = a.ws + WS_W + (size_t)l * W_LAYER;
        if (r < 2 * I_UP) { const int f = r / I_UP; r %= I_UP; const int kb = r / 176, db = r % 176;
            const int tile = db >> 3, half = (db >> 2) & 1, q = db & 3;
            tr_item((f ? a.in[I_F2UP] : a.in[I_F1UP]) + (size_t)l * D * NUP, NUP, half * DFF + tile * 128 + q * 32, (bf16*)(wl + (f ? WO_UP2 : WO_UP1)), D, db * 32, kb * 64, scr, lane, false); continue; }
        r -= 2 * I_UP;
        if (r < 2 * I_DN) { const int f = r / I_DN; r %= I_DN; const int kb = r / 32, db = r % 32;
            tr_item((f ? a.in[I_F2DN] : a.in[I_F1DN]) + (size_t)l * DFF * D, D, db * 32, (bf16*)(wl + (f ? WO_DN2 : WO_DN1)), DFF, db * 32, kb * 64, scr, lane, false); continue; }
        r -= 2 * I_DN;
        if (r < I_IN) { const int kb = r / 80, db = r % 80;
            const int src = db < 48 ? db * 32 : (db < 72 ? db * 32 + 32 : 1536);
            tr_item(a.in[I_WIN] + (size_t)l * D * DIN, DIN, src, (bf16*)(wl + WO_IN), D, db * 32, kb * 64, scr, lane, db > 72); continue; }
        r -= I_IN;
        { const int kb = r / 32, db = r % 32;
          tr_item(a.in[I_WOUT] + (size_t)l * D * D, D, db * 32, (bf16*)(wl + WO_OUT), D, db * 32, kb * 64, scr, lane, false); }
    }
    for (int e = blockIdx.x * NTHREADS + tid; e < 2 * 64 * 1024; e += G * NTHREADS) {
        const int n = e & 1023, kg = (e >> 10) & 63, l = e >> 16, k0 = 512 + 8 * kg;
        const float* wo = a.in[I_WOUT] + (size_t)l * D * D;
        float acc[8];
#pragma unroll
        for (int q = 0; q < 8; ++q) acc[q] = 0.f;
        if (k0 < 768) { const int gi = (k0 - 512) >> 6, i0 = (k0 - 512) & 63;
            const float* pw = a.in[I_POOLW] + ((size_t)(l * 4 + gi) * 64 + i0) * 64; const float* sc = a.in[I_POOLS] + l * 256 + gi * 64;
            for (int j0 = 0; j0 < 64; j0 += 16) { float w[16];
#pragma unroll
                for (int jj = 0; jj < 16; ++jj) w[jj] = wo[(size_t)(512 + gi * 64 + j0 + jj) * D + n];
#pragma unroll
                for (int jj = 0; jj < 16; ++jj) { const float ws = w[jj] * sc[j0 + jj];
#pragma unroll
                    for (int q = 0; q < 8; ++q) acc[q] += pw[q * 64 + j0 + jj] * ws; } }
        } else { const int i0 = k0 - 768; const float* pw = a.in[I_CPW] + ((size_t)l * 256 + i0) * 256;
            for (int j0 = 0; j0 < 256; j0 += 16) { float w[16];
#pragma unroll
                for (int jj = 0; jj < 16; ++jj) w[jj] = wo[(size_t)(768 + j0 + jj) * D + n];
#pragma unroll
                for (int jj = 0; jj < 16; ++jj) {
#pragma unroll
                    for (int q = 0; q < 8; ++q) acc[q] += pw[q * 256 + j0 + jj] * w[jj]; } }
        }
        u32x4v o; o.x = pk2(acc[0], acc[1]); o.y = pk2(acc[2], acc[3]); o.z = pk2(acc[4], acc[5]); o.w = pk2(acc[6], acc[7]);
        *(u32x4v*)((bf16*)(a.ws + WS_W + (size_t)l * W_LAYER + WO_OUT) + (size_t)n * D + k0) = o;
    }
    for (int e = blockIdx.x * NTHREADS + tid; e < 2 * 1024; e += G * NTHREADS) {
        const int n = e & 1023, l = e >> 10; const float* wo = a.in[I_WOUT] + (size_t)l * D * D; const float* pb = a.in[I_CPWB] + l * 256;
        float s = 0.f;
        for (int j0 = 0; j0 < 256; j0 += 16) { float w[16];
#pragma unroll
            for (int jj = 0; jj < 16; ++jj) w[jj] = wo[(size_t)(768 + j0 + jj) * D + n];
#pragma unroll
            for (int jj = 0; jj < 16; ++jj) s += pb[j0 + jj] * w[jj]; }
        ((float*)(a.ws + WS_BOUT))[e] = s;
    }
    __syncthreads();
    float* sc = (float*)lds;
    float* red = (float*)(lds + 17 * 4096);
    for (int e = tid; e < 17 * 1024; e += NTHREADS) { const float v = e < 16 * 1024 ? a.in[I_C][e] : a.in[I_CCTX][e - 16 * 1024]; sc[e] = silu(v); }
    __syncthreads();
    for (int it = blockIdx.x; it < 2 * 288; it += G) {
        const int l = it / 288, n0 = (it % 288) * 32, col = tid & 31, ks = tid >> 5;
        const float* w = a.in[I_WADA] + (size_t)l * D * (NMOD * D) + n0 + col;
        float acc[17];
#pragma unroll
        for (int r = 0; r < 17; ++r) acc[r] = 0.f;
        for (int k0 = ks * 64; k0 < ks * 64 + 64; k0 += 16) { float wv[16];
#pragma unroll
            for (int kk = 0; kk < 16; ++kk) wv[kk] = w[(size_t)(k0 + kk) * (NMOD * D)];
#pragma unroll
            for (int kk = 0; kk < 16; ++kk) {
#pragma unroll
                for (int r = 0; r < 17; ++r) acc[r] += sc[r * 1024 + k0 + kk] * wv[kk]; } }
#pragma unroll
        for (int r = 0; r < 17; ++r) red[(ks * 17 + r) * 32 + col] = acc[r];
        __syncthreads();
        for (int e = tid; e < 17 * 32; e += NTHREADS) { const int r = e >> 5, c2 = e & 31; float s = a.in[I_BADA][l * NMOD * D + n0 + c2];
            for (int q = 0; q < 16; ++q) s += red[(q * 17 + r) * 32 + c2];
            ((float*)(a.ws + WS_MODS))[((size_t)l * 17 + r) * (NMOD * D) + n0 + c2] = s; }
        __syncthreads();
    }
}

struct NormP {
    const float* xin_lat; const float* xin_ctx; float* xout_lat; float* xout_ctx;
    bf16* xr; int x_f32, out_f32;
    const bf16* Y; const float* gate; float w; const float* g_post; int has_y;
    const float* shift; const float* scale; const float* g_pre; bf16* H; int has_next; int nrows;
};
__device__ __forceinline__ float sumsq4(const f32x4 (&v)[4]) { float ss = 0.f;
#pragma unroll
    for (int j = 0; j < 4; ++j) ss += (v[j].x * v[j].x + v[j].y * v[j].y) + (v[j].z * v[j].z + v[j].w * v[j].w);
    return ss; }
struct NormVec { f32x4 vA[4], vB[4], vS[4]; int cur_b; };
__device__ __forceinline__ void norm_load(const NormP& p, int r, int lane, f32x4 (&x)[4], u32x2v (&y)[4]) {
    if (p.x_f32) { const float* xr = r < TL ? p.xin_lat + (size_t)r * D : p.xin_ctx + (size_t)(r - TL) * D;
#pragma unroll
        for (int j = 0; j < 4; ++j) x[j] = __builtin_nontemporal_load((const f32x4*)xr + lane + 64 * j); }
    else {
#pragma unroll
        for (int j = 0; j < 4; ++j) { const u32x2v t = __builtin_nontemporal_load((const u32x2v*)(p.xr + (size_t)r * D) + lane + 64 * j); x[j] = (f32x4){bflo(t.x), bfhi(t.x), bflo(t.y), bfhi(t.y)}; } }
    if (p.has_y) {
#pragma unroll
        for (int j = 0; j < 4; ++j) y[j] = __builtin_nontemporal_load((const u32x2v*)(p.Y + (size_t)r * D) + lane + 64 * j); }
}
__device__ __forceinline__ void norm_row(const NormP& p, int r, int lane, f32x4 (&v)[4], const u32x2v (&yr)[4], NormVec& c) {
    const int b = r < TL ? (r >> 12) : 16;
    if (b != c.cur_b) { c.cur_b = b;
        if (p.has_y) { const f32x4* gt = (const f32x4*)(p.gate + (size_t)b * (NMOD * D)); const f32x4* gp = (const f32x4*)p.g_post;
#pragma unroll
            for (int j = 0; j < 4; ++j) c.vA[j] = gt[lane + 64 * j] * gp[lane + 64 * j] * p.w; }
        if (p.has_next) { const f32x4* sh = (const f32x4*)(p.shift + (size_t)b * (NMOD * D)); const f32x4* sc = (const f32x4*)(p.scale + (size_t)b * (NMOD * D)); const f32x4* gp = (const f32x4*)p.g_pre;
#pragma unroll
            for (int j = 0; j < 4; ++j) { c.vB[j] = gp[lane + 64 * j] * (sc[lane + 64 * j] + 1.0f); c.vS[j] = sh[lane + 64 * j]; } } }
    if (p.has_y) {
        f32x4 y[4];
#pragma unroll
        for (int j = 0; j < 4; ++j) y[j] = (f32x4){bflo(yr[j].x), bfhi(yr[j].x), bflo(yr[j].y), bfhi(yr[j].y)};
        const float rs = rsqrtf(wave_sum(sumsq4(y)) * (1.f / D) + EPS);
#pragma unroll
        for (int j = 0; j < 4; ++j) v[j] = v[j] + c.vA[j] * (y[j] * rs);
        if (p.out_f32) {
#pragma unroll
            for (int j = 0; j < 4; ++j) __builtin_nontemporal_store(v[j], (f32x4*)(p.xout_lat + (size_t)r * D) + lane + 64 * j); }
        else {
#pragma unroll
            for (int j = 0; j < 4; ++j) { u32x2v o; o.x = pk2(v[j].x, v[j].y); o.y = pk2(v[j].z, v[j].w); __builtin_nontemporal_store(o, (u32x2v*)(p.xr + (size_t)r * D) + lane + 64 * j); } }
    }
    if (p.has_next) {
        const float rs = rsqrtf(wave_sum(sumsq4(v)) * (1.f / D) + EPS);
        u32x2v* ho = (u32x2v*)(p.H + (size_t)r * D);
#pragma unroll
        for (int j = 0; j < 4; ++j) { const f32x4 h = v[j] * rs * c.vB[j] + c.vS[j];
            u32x2v o; o.x = pk2(h.x, h.y); o.y = pk2(h.z, h.w); ho[lane + 64 * j] = o; }
    }
}
__device__ __forceinline__ void norm_phase(const NormP& p, int lane, int gw, int NGW) {
    const int rpw = p.nrows / NGW, rbeg = gw * rpw, rend = rbeg + rpw;
    NormVec c; c.cur_b = -1;
    f32x4 xa[4], xb[4], v[4]; u32x2v ya[4], yb[4], yv[4];
    norm_load(p, rbeg, lane, xa, ya); norm_load(p, rbeg + 1, lane, xb, yb);
#pragma unroll 1
    for (int r = rbeg; r < rend; r += 2) {
#pragma unroll
        for (int j = 0; j < 4; ++j) { v[j] = xa[j]; yv[j] = ya[j]; }
        norm_load(p, min(r + 2, rend - 1), lane, xa, ya);
        norm_row(p, r, lane, v, yv, c);
#pragma unroll
        for (int j = 0; j < 4; ++j) { v[j] = xb[j]; yv[j] = yb[j]; }
        norm_load(p, min(r + 3, rend - 1), lane, xb, yb);
        norm_row(p, r + 1, lane, v, yv, c);
    }
}

constexpr int GL_G = 0, GL_ATT = 0, GL_LR = 32768, GL_SEG = 40960, GL_TT = 43008, GL_SS = 43520, GL_QT = 44032, GL_KA = 62464, GL_VT = 80896, GL_SB = 99328;
constexpr int RP = 72;
__device__ __forceinline__ int swz_off(int row, int tok) { return row * 64 + ((((tok >> 3) ^ row ^ (row >> 3)) & 7) << 3) + (tok & 7); }

__device__ __forceinline__ void gla_gk(const bf16* P, int row0, int h, const float* w2, const float* bgk, unsigned char* lds, int tid) {
    float* LR = (float*)(lds + GL_LR); float* SEG = (float*)(lds + GL_SEG); float* TT = (float*)(lds + GL_TT); float* G = (float*)(lds + GL_G);
    { const int tok = tid >> 3, c4 = (tid & 7) * 4; const u32x2v raw = *(const u32x2v*)(P + (size_t)(row0 + tok) * PSTR + PC_LR + c4);
      LR[tok * 32 + c4 + 0] = bflo(raw.x); LR[tok * 32 + c4 + 1] = bfhi(raw.x); LR[tok * 32 + c4 + 2] = bflo(raw.y); LR[tok * 32 + c4 + 3] = bfhi(raw.y); }
    const int d = tid >> 8, tq = (tid >> 6) & 3, k = tid & 63;
    float w[16];
#pragma unroll
    for (int r = 0; r < 16; ++r) w[r] = w2[(d * 16 + r) * 256 + h * 64 + k];
    const float bias = bgk[d * 256 + h * 64 + k];
    __syncthreads();
    float p[16]; float run = 0.f;
#pragma unroll
    for (int i = 0; i < 16; ++i) { const float* lr = LR + (16 * tq + i) * 32 + d * 16; float logit = bias;
#pragma unroll
        for (int r = 0; r < 16; ++r) logit += lr[r] * w[r];
        const float gk = logsigmoid_f(logit) * (1.0f / 16.0f);
        if (d == 0) { run += gk; p[i] = run; } else { p[i] = run; run += gk; } }
    SEG[(d * 4 + tq) * 64 + k] = run;
    __syncthreads();
    float off = 0.f, tot = 0.f;
#pragma unroll
    for (int q = 0; q < 4; ++q) { const float s = SEG[(d * 4 + q) * 64 + k]; tot += s; if (q < tq) off += s; }
#pragma unroll
    for (int i = 0; i < 16; ++i) G[(d * 64 + 16 * tq + i) * 64 + k] = p[i] + off;
    if (tq == 0) TT[d * 64 + k] = tot;
    __syncthreads();
}
__device__ __forceinline__ void gla_load_v(const bf16* P, int row0, int h, int tid, u32x4v (&raw)[2]) {
#pragma unroll
    for (int rep = 0; rep < 2; ++rep) { const int idx = tid + rep * NTHREADS, tok = idx >> 4, vg = idx & 15; raw[rep] = *(const u32x4v*)(P + (size_t)(row0 + tok) * PSTR + PC_V + h * 128 + vg * 8); }
}
__device__ __forceinline__ void gla_store_vt(const u32x4v (&rawv)[2], unsigned char* lds, int tid) {
    bf16* VT = (bf16*)(lds + GL_VT);
#pragma unroll
    for (int rep = 0; rep < 2; ++rep) { const int idx = tid + rep * NTHREADS, tok = idx >> 4, vg = idx & 15; const u32x4v raw = rawv[rep];
        const unsigned wv[4] = {raw.x, raw.y, raw.z, raw.w};
#pragma unroll
        for (int q = 0; q < 8; ++q) VT[swz_off(vg * 8 + q, tok)] = (bf16)((q & 1) ? (wv[q >> 1] >> 16) : (wv[q >> 1] & 0xffff)); }
}
#define FRAG(base, row, kk) (*(const bf16x8*)((base) + ((row) + fr) * RP + (kk) * 32 + fq * 8))
#define FRAGS(base, row, kk) (*(const bf16x8*)((base) + swz_off((row) + fr, (kk) * 32 + fq * 8)))

__device__ __forceinline__ void gla_pass_a(const KArgs& a, int l, int cid, int h, unsigned char* lds, int tid, int lane, int wave) {
    const bf16* P = (const bf16*)(a.ws + WS_ACT); const int row0 = cid * 64, u = cid * 4 + h;
    const u32x4v kraw = *(const u32x4v*)(P + (size_t)(row0 + (tid >> 3)) * PSTR + PC_K + h * 64 + (tid & 7) * 8); u32x4v vraw[2]; gla_load_v(P, row0, h, tid, vraw);
    gla_gk(P, row0, h, a.in[I_WGK2] + (size_t)l * 2 * 16 * 256, a.in[I_BGK] + l * 2 * 256, lds, tid);
    const float* G = (const float*)(lds + GL_G); const float* TT = (const float*)(lds + GL_TT);
    bf16* KT = (bf16*)(lds + GL_QT);
    { const int tok = tid >> 3, kg = tid & 7; float kv[8]; unpack8(kraw, kv);
#pragma unroll
      for (int q = 0; q < 8; ++q) { const int kc = kg * 8 + q; const float a0 = G[tok * 64 + kc], a1 = G[(64 + tok) * 64 + kc];
          KT[swz_off(kc, tok)] = (bf16)f2bf(kv[q] * __expf(TT[kc] - a0)); KT[64 * 64 + swz_off(kc, tok)] = (bf16)f2bf(kv[q] * __expf(a1)); } }
    gla_store_vt(vraw, lds, tid);
    if (tid < 128) ((float*)(a.ws + WS_DC))[(size_t)(u * 2 + (tid >> 6)) * 64 + (tid & 63)] = __expf(TT[tid]);
    __syncthreads();
    const int fr = lane & 15, fq = lane >> 4, d = wave >> 2, kt = wave & 3;
    const bf16* VT = (const bf16*)(lds + GL_VT); const bf16* KTd = KT + d * 64 * 64;
    const bf16x8 b0 = FRAGS(KTd, kt * 16, 0), b1 = FRAGS(KTd, kt * 16, 1);
    bf16* ST = (bf16*)(a.ws + WS_Y) + (size_t)(u * 2 + d) * 8192;
#pragma unroll
    for (int vt = 0; vt < 8; ++vt) { f32x4 c = {0.f, 0.f, 0.f, 0.f};
        c = __builtin_amdgcn_mfma_f32_16x16x32_bf16(b0, FRAGS(VT, vt * 16, 0), c, 0, 0, 0);
        c = __builtin_amdgcn_mfma_f32_16x16x32_bf16(b1, FRAGS(VT, vt * 16, 1), c, 0, 0, 0);
        u32x2v o; o.x = pk2(c[0], c[1]); o.y = pk2(c[2], c[3]); *(u32x2v*)(ST + (vt * 16 + fr) * 64 + kt * 16 + fq * 4) = o; }
    __syncthreads();
}

__device__ __forceinline__ void gla_scan(const KArgs& a, int tid, int G) {
    bf16* STb = (bf16*)(a.ws + WS_Y); const float* DCb = (const float*)(a.ws + WS_DC);
    for (int it = blockIdx.x; it < 256; it += G) {
        const int chain = it >> 1, half = it & 1, b = chain >> 3, h = (chain >> 1) & 3, d = chain & 1;
        const int e0 = half * 4096 + tid * 8, k0 = e0 & 63;
        f32x4 s0 = {0.f, 0.f, 0.f, 0.f}, s1 = {0.f, 0.f, 0.f, 0.f};
#define CID_OF(step) (((step) < 4) ? (1024 + b * 4 + (d ? 3 - (step) : (step))) : (b * 64 + (d ? (67 - (step)) : ((step) - 4))))
#define UB_OF(step) ((size_t)((CID_OF(step) * 4 + h) * 2 + d))
        u32x4v rd[16]; f32x4 rc0[4], rc1[4];
#pragma unroll
        for (int q = 0; q < 16; ++q) { const size_t ub = UB_OF(q); rd[q] = *(const u32x4v*)(STb + ub * 8192 + e0); }
#pragma unroll
        for (int q = 0; q < 4; ++q) { const size_t ub = UB_OF(q); rc0[q] = *(const f32x4*)(DCb + ub * 64 + k0); rc1[q] = *(const f32x4*)(DCb + ub * 64 + k0 + 4); }
#pragma unroll 1
        for (int sb = 0; sb < 68; sb += 16) {
#pragma unroll
            for (int q = 0; q < 16; ++q) { const int step = sb + q;
                if (step < 68) { const size_t ub = UB_OF(step); bf16* cur = STb + ub * 8192 + e0;
                    const u32x4v dr = rd[q]; const f32x4 c0 = rc0[q & 3], c1 = rc1[q & 3];
                    if (step + 16 < 68) { const size_t un = UB_OF(step + 16); rd[q] = *(const u32x4v*)(STb + un * 8192 + e0); }
                    if (step + 4 < 68) { const size_t un = UB_OF(step + 4); rc0[q & 3] = *(const f32x4*)(DCb + un * 64 + k0); rc1[q & 3] = *(const f32x4*)(DCb + un * 64 + k0 + 4); }
                    u32x4v o; o.x = pk2(s0.x, s0.y); o.y = pk2(s0.z, s0.w); o.z = pk2(s1.x, s1.y); o.w = pk2(s1.z, s1.w); *(u32x4v*)cur = o;
                    const f32x4 d0 = {bflo(dr.x), bfhi(dr.x), bflo(dr.y), bfhi(dr.y)}, d1 = {bflo(dr.z), bfhi(dr.z), bflo(dr.w), bfhi(dr.w)};
                    s0 = c0 * s0 + d0; s1 = c1 * s1 + d1; } }
        }
#undef UB_OF
    }
}

__device__ __forceinline__ void gla_pass_c(const KArgs& a, int l, int cid, int h, unsigned char* lds, int tid, int lane, int wave) {
    const bf16* P = (const bf16*)(a.ws + WS_ACT); const int row0 = cid * 64, u = cid * 4 + h;
    const u32x4v qraw = *(const u32x4v*)(P + (size_t)(row0 + (tid >> 3)) * PSTR + PC_Q + h * 64 + (tid & 7) * 8), kraw = *(const u32x4v*)(P + (size_t)(row0 + (tid >> 3)) * PSTR + PC_K + h * 64 + (tid & 7) * 8);
    u32x4v vraw[2]; gla_load_v(P, row0, h, tid, vraw);
    u32x4v sraw[4];
    { const u32x4v* ST = (const u32x4v*)((const bf16*)(a.ws + WS_Y) + (size_t)(u * 2) * 8192);
#pragma unroll
      for (int rep = 0; rep < 4; ++rep) sraw[rep] = ST[tid + rep * NTHREADS]; }
    gla_gk(P, row0, h, a.in[I_WGK2] + (size_t)l * 2 * 16 * 256, a.in[I_BGK] + l * 2 * 256, lds, tid);
    const float* G = (const float*)(lds + GL_G); const float* TT = (const float*)(lds + GL_TT);
    bf16* QT = (bf16*)(lds + GL_QT); bf16* KA = (bf16*)(lds + GL_KA); bf16* SB = (bf16*)(lds + GL_SB); bf16* ATT = (bf16*)(lds + GL_ATT); float* SS = (float*)(lds + GL_SS);
    { const int tok = tid >> 3, kg = tid & 7; float qv[8], kv[8];
      unpack8(qraw, qv); unpack8(kraw, kv);
      float q0[8], k0[8], q1[8], k1[8];
#pragma unroll
      for (int q = 0; q < 8; ++q) { const int kc = kg * 8 + q; const float a0 = G[tok * 64 + kc], a1 = G[(64 + tok) * 64 + kc], tb = TT[64 + kc];
          q0[q] = qv[q] * 0.125f * __expf(a0); k0[q] = kv[q] * __expf(-a0); q1[q] = qv[q] * 0.125f * __expf(tb - a1); k1[q] = kv[q] * __expf(a1 - tb); }
      u32x4v o;
      o.x = pk2(q0[0], q0[1]); o.y = pk2(q0[2], q0[3]); o.z = pk2(q0[4], q0[5]); o.w = pk2(q0[6], q0[7]); *(u32x4v*)(QT + tok * RP + kg * 8) = o;
      o.x = pk2(q1[0], q1[1]); o.y = pk2(q1[2], q1[3]); o.z = pk2(q1[4], q1[5]); o.w = pk2(q1[6], q1[7]); *(u32x4v*)(QT + (64 + tok) * RP + kg * 8) = o;
      o.x = pk2(k0[0], k0[1]); o.y = pk2(k0[2], k0[3]); o.z = pk2(k0[4], k0[5]); o.w = pk2(k0[6], k0[7]); *(u32x4v*)(KA + tok * RP + kg * 8) = o;
      o.x = pk2(k1[0], k1[1]); o.y = pk2(k1[2], k1[3]); o.z = pk2(k1[4], k1[5]); o.w = pk2(k1[6], k1[7]); *(u32x4v*)(KA + (64 + tok) * RP + kg * 8) = o; }
    gla_store_vt(vraw, lds, tid);
#pragma unroll
    for (int rep = 0; rep < 4; ++rep) { const int idx = tid + rep * NTHREADS; *(u32x4v*)(SB + (idx >> 3) * RP + (idx & 7) * 8) = sraw[rep]; }
    __syncthreads();
    const int fr = lane & 15, fq = lane >> 4;
    {
        const int d = wave >> 2, ib = wave & 3; const bf16* QTd = QT + d * 64 * RP; const bf16* KAd = KA + d * 64 * RP; bf16* ATd = ATT + d * 64 * RP;
        const bf16x8 qa0 = FRAG(QTd, ib * 16, 0), qa1 = FRAG(QTd, ib * 16, 1);
#pragma unroll
        for (int jb = 0; jb < 4; ++jb) { f32x4 c = {0.f, 0.f, 0.f, 0.f};
            const bool live = d ? (jb >= ib) : (jb <= ib);
            if (live) { c = __builtin_amdgcn_mfma_f32_16x16x32_bf16(FRAG(KAd, jb * 16, 0), qa0, c, 0, 0, 0); c = __builtin_amdgcn_mfma_f32_16x16x32_bf16(FRAG(KAd, jb * 16, 1), qa1, c, 0, 0, 0); }
            const int i = ib * 16 + fr, j0 = jb * 16 + fq * 4;
#pragma unroll
            for (int r = 0; r < 4; ++r) { const int j = j0 + r; const bool keep = d ? (j >= i) : (j <= i); if (!keep) c[r] = 0.f; }
            u32x2v o; o.x = pk2(c[0], c[1]); o.y = pk2(c[2], c[3]); *(u32x2v*)(ATd + i * RP + j0) = o; }
    }
    __syncthreads();
    const int ib = wave & 3, vh = wave >> 2; const bf16* VT = (const bf16*)(lds + GL_VT);
    f32x4 acc[4];
#pragma unroll
    for (int vt = 0; vt < 4; ++vt) acc[vt] = (f32x4){0.f, 0.f, 0.f, 0.f};
#pragma unroll
    for (int d = 0; d < 2; ++d)
#pragma unroll
        for (int kk = 0; kk < 2; ++kk) { const bf16x8 fa = FRAG(ATT + d * 64 * RP, ib * 16, kk), fqv = FRAG(QT + d * 64 * RP, ib * 16, kk);
#pragma unroll
            for (int vt = 0; vt < 4; ++vt) { const int v0 = vh * 64 + vt * 16;
                acc[vt] = __builtin_amdgcn_mfma_f32_16x16x32_bf16(FRAGS(VT, v0, kk), fa, acc[vt], 0, 0, 0);
                acc[vt] = __builtin_amdgcn_mfma_f32_16x16x32_bf16(FRAG(SB + d * 128 * RP, v0, kk), fqv, acc[vt], 0, 0, 0); } }
    float ss = 0.f;
#pragma unroll
    for (int vt = 0; vt < 4; ++vt) ss += (acc[vt].x * acc[vt].x + acc[vt].y * acc[vt].y) + (acc[vt].z * acc[vt].z + acc[vt].w * acc[vt].w);
    ss += __shfl_xor(ss, 16); ss += __shfl_xor(ss, 32);
    if (fq == 0) SS[vh * 64 + ib * 16 + fr] = ss;
    __syncthreads();
    const int i = ib * 16 + fr; const float rs = rsqrtf((SS[i] + SS[64 + i]) * (1.0f / 128.0f) + EPS);
    const float* gg = a.in[I_GLAG] + l * 128; bf16* Z = (bf16*)(a.ws + WS_H);
#pragma unroll
    for (int vt = 0; vt < 4; ++vt) { const int v = vh * 64 + vt * 16 + fq * 4; const f32x4 gn = *(const f32x4*)(gg + v);
        const u32x2v graw = *(const u32x2v*)(P + (size_t)(row0 + i) * PSTR + PC_G + h * 128 + v);
        const float o0 = acc[vt].x * rs * gn.x * silu(bflo(graw.x)), o1 = acc[vt].y * rs * gn.y * silu(bfhi(graw.x)), o2 = acc[vt].z * rs * gn.z * silu(bflo(graw.y)), o3 = acc[vt].w * rs * gn.w * silu(bfhi(graw.y));
        u32x2v o; o.x = pk2(o0, o1); o.y = pk2(o2, o3); *(u32x2v*)(Z + (size_t)(row0 + i) * D + h * 128 + v) = o; }
    __syncthreads();
}

template <int W> __device__ __forceinline__ void pool_hsum(const float* V, const float* Us, bf16* zo, int ch, int tp, int pos0, int n) {
    constexpr int lo = W / 2, hi = W - 1 - lo;
#pragma unroll 4
    for (int tt = 0; tt < 32; ++tt) { const int tok = tp * 32 + tt, pos = pos0 + tok; float s = 0.f;
#pragma unroll
        for (int c = -lo; c <= hi; ++c) s += V[(8 + tok + c) * 256 + ch];
        const int cnt = min(pos + hi + 1, n) - max(pos - lo, 0);
        zo[(size_t)tok * D] = (bf16)f2bf(s / (float)cnt - Us[tok * 256 + ch]); }
}
__device__ __forceinline__ void pool_unit(const KArgs& a, bool grid, int b, int rs, unsigned char* lds, int tid) {
    const bf16* P = (const bf16*)(a.ws + WS_ACT); bf16* Z = (bf16*)(a.ws + WS_H); float* V = (float*)lds;
    float* U = (float*)(lds + 80 * 1024);
    int rowbase, pos0, n;
    if (grid) {
        rowbase = b * SEQ + rs * 64; pos0 = 0; n = 64;
        for (int e = tid; e < 16 * 256; e += NTHREADS) { const int rr = e >> 8; V[((rr < 8) ? rr : (64 + rr)) * 256 + (e & 255)] = 0.f; }
        const int tok = tid >> 3, c8 = (tid & 7) * 8; const bf16* pb = P + (size_t)(b * SEQ + tok) * PSTR + PC_POOL + c8;
#pragma unroll
        for (int gi = 0; gi < 4; ++gi) { const int w = 2 << gi, lo = w >> 1, hi = w - 1 - lo; float acc[8];
#pragma unroll
            for (int q = 0; q < 8; ++q) acc[q] = 0.f;
#pragma unroll
            for (int off = -lo; off <= hi; ++off) { const int rr = rs + off, rc = min(max(rr, 0), 63); const float msk = (rr == rc) ? 1.f : 0.f; float f[8];
                unpack8(*(const u32x4v*)(pb + (size_t)rc * 64 * PSTR + gi * 64), f);
#pragma unroll
                for (int q = 0; q < 8; ++q) acc[q] += f[q] * msk;
                if (off == 0) { float* ud = U + tok * 256 + gi * 64 + c8; *(f32x4*)ud = (f32x4){f[0], f[1], f[2], f[3]}; *(f32x4*)(ud + 4) = (f32x4){f[4], f[5], f[6], f[7]}; } }
            const float inv = 1.0f / (float)(min(rs + hi, 63) - max(rs - lo, 0) + 1);
            float* dst = V + (8 + tok) * 256 + gi * 64 + c8;
            *(f32x4*)dst = (f32x4){acc[0] * inv, acc[1] * inv, acc[2] * inv, acc[3] * inv}; *(f32x4*)(dst + 4) = (f32x4){acc[4] * inv, acc[5] * inv, acc[6] * inv, acc[7] * inv};
            if (gi == 1) asm volatile("" ::: "memory"); }
    } else {
        rowbase = TL + b * CTXL + rs * 64; pos0 = rs * 64; n = CTXL;
#pragma unroll
        for (int i = 0; i < 5; ++i) { const int e = tid + i * NTHREADS, tt = e >> 5, c8 = (e & 31) * 8, t = pos0 - 8 + tt, tc = min(max(t, 0), CTXL - 1); const float msk = (t == tc) ? 1.f : 0.f; float f[8];
            unpack8(*(const u32x4v*)(P + (size_t)(TL + b * CTXL + tc) * PSTR + PC_POOL + c8), f);
            float* dst = V + tt * 256 + c8; *(f32x4*)dst = (f32x4){f[0] * msk, f[1] * msk, f[2] * msk, f[3] * msk}; *(f32x4*)(dst + 4) = (f32x4){f[4] * msk, f[5] * msk, f[6] * msk, f[7] * msk}; }
    }
    __syncthreads();
    { const int ch = tid & 255, tp = tid >> 8, gi = __builtin_amdgcn_readfirstlane(ch >> 6); const float* Us = grid ? U : V + 8 * 256; bf16* zo = Z + (size_t)rowbase * D + 512 + ch;
      if (gi == 0) pool_hsum<2>(V, Us, zo, ch, tp, pos0, n); else if (gi == 1) pool_hsum<4>(V, Us, zo, ch, tp, pos0, n); else if (gi == 2) pool_hsum<8>(V, Us, zo, ch, tp, pos0, n); else pool_hsum<16>(V, Us, zo, ch, tp, pos0, n); }
    __syncthreads();
}

__device__ __forceinline__ void conv_unit(const KArgs& a, int l, int seqrow0, int t0, int n, unsigned char* lds, int tid, int lane, int wave) {
    const bf16* P = (const bf16*)(a.ws + WS_ACT); bf16* Z = (bf16*)(a.ws + WS_H);
    float* Hh = (float*)lds;
    float* CO = (float*)(lds + 94 * 1024);
#pragma unroll
    for (int i = 0; i < 6; ++i) { const int e = min(tid + i * NTHREADS, 94 * 32 - 1), tt = e >> 5, c8 = (e & 31) * 8, t = t0 - 15 + tt, tc = min(max(t, 0), n - 1); const float msk = (t == tc) ? 1.f : 0.f; float h[8], av[8], gv[8];
        const bf16* pr = P + (size_t)(seqrow0 + tc) * PSTR; unpack8(*(const u32x4v*)(pr + PC_CA + c8), av); unpack8(*(const u32x4v*)(pr + PC_CG + c8), gv);
#pragma unroll
        for (int q = 0; q < 8; ++q) h[q] = av[q] * sigmoid_f(gv[q]) * msk;
        float* dst = Hh + tt * 256 + c8; *(f32x4*)dst = (f32x4){h[0], h[1], h[2], h[3]}; *(f32x4*)(dst + 4) = (f32x4){h[4], h[5], h[6], h[7]}; }
    __syncthreads();
    { const int ch = tid & 255, half = tid >> 8; const float* dw = a.in[I_CDW] + (size_t)l * 31 * 256 + ch; float w[31];
#pragma unroll
      for (int j = 0; j < 31; ++j) w[j] = dw[j * 256];
      const float bias = a.in[I_CDWB][l * 256 + ch];
#pragma unroll 1
      for (int tb = 0; tb < 8; ++tb) { const int tok0 = half * 32 + tb * 4; float acc[4] = {bias, bias, bias, bias};
#pragma unroll
          for (int jj = 0; jj < 34; ++jj) { const float x = Hh[(tok0 + jj) * 256 + ch];
#pragma unroll
              for (int o = 0; o < 4; ++o) { const int j = jj - o; if (j >= 0 && j < 31) acc[o] += x * w[j]; } }
#pragma unroll
          for (int o = 0; o < 4; ++o) CO[(tok0 + o) * 256 + ch] = acc[o]; } }
    __syncthreads();
    { const f32x4 g = *(const f32x4*)(a.in[I_CLNG] + l * 256 + lane * 4), bb = *(const f32x4*)(a.in[I_CLNB] + l * 256 + lane * 4);
#pragma unroll
      for (int tt = 0; tt < 8; ++tt) { const int tok = wave + 8 * tt; const f32x4 x = *(const f32x4*)(CO + tok * 256 + lane * 4);
          const float mean = wave_sum((x.x + x.y) + (x.z + x.w)) * (1.0f / 256.0f); const f32x4 dlt = x - mean;
          const float var = wave_sum((dlt.x * dlt.x + dlt.y * dlt.y) + (dlt.z * dlt.z + dlt.w * dlt.w)) * (1.0f / 256.0f); const float rs = rsqrtf(var + EPS);
          const f32x4 y = dlt * rs * g + bb;
          u32x2v o; o.x = pk2(silu(y.x), silu(y.y)); o.y = pk2(silu(y.z), silu(y.w));
          *(u32x2v*)(Z + (size_t)(seqrow0 + t0 + tok) * D + 768 + lane * 4) = o; } }
    __syncthreads();
}

__global__ void __launch_bounds__(NTHREADS, 2) fwd_megakernel(KArgs kargs_unused) {
    extern __shared__ __attribute__((aligned(16))) unsigned char lds[];
    cg::grid_group grid = cg::this_grid();
    const int G = gridDim.x;
    volatile LAS unsigned* bst = (volatile LAS unsigned*)((LAS unsigned char*)lds + (LDS_BYTES - 16));
    if (threadIdx.x < 4) bst[threadIdx.x] = 0u;
    __syncthreads();
    XcdBarrier xbar; { const KArgs a0 = load_args(); xbar = xcd_barrier_post((unsigned*)(a0.ws + WS_BAR), bst); }
#define GRID_SYNC() xcd_barrier(xbar)
#ifndef NO_PREP
    { PHASE_LOCALS prep_phase(a, lds, tid, lane, wave, G); }
#endif
    if (G > 65535) grid.sync();
    GRID_SYNC();
    {
        PHASE_LOCALS
        const float* MODS = (const float*)(a.ws + WS_MODS);
        const NormP p{a.in[I_X], a.in[I_CTX], nullptr, nullptr, nullptr, 1, 0, nullptr, nullptr, 0.f, nullptr, 0, MODS + 0 * D, MODS + 1 * D, a.in[I_NORMG], (bf16*)(a.ws + WS_H), 1, TT_ROWS};
#ifndef NO_NORM
        norm_phase(p, lane, blockIdx.x * NWAVES + wave, G * NWAVES);
#endif
    }
    GRID_SYNC();
#pragma unroll 1
    for (int l = 0; l < 2; ++l) {
        const bool last = (l == 1);
#pragma unroll 1
        for (int sl = 0; sl < 3; ++sl) {
            const int Mrows = (last && sl == 2) ? TL : TT_ROWS;
            { const KArgs a = load_args(); const unsigned char* wl = a.ws + WS_W + (size_t)l * W_LAYER;
              pg8::Gemm g{(const bf16*)(a.ws + WS_H), (const bf16*)(wl + (sl == 0 ? WO_UP1 : (sl == 2 ? WO_UP2 : WO_IN))), Mrows, sl == 1 ? NIN : NUP, D};
              pg8::StaticOrder S; S.init(g.M, g.N, G, (int)blockIdx.x);
              pg8::EpiBf16 E{(bf16*)(a.ws + WS_ACT), sl == 1 ? NIN : DFF, sl == 1 ? 0 : 1, nullptr};
#ifndef NO_GEMM1
              pg8::gemm_phase<pg8::EpiBf16, pg8::StaticOrder, true, true>((PG8_LAS unsigned char*)lds, g, S, E);
#endif
            }
            GRID_SYNC();
            int M2 = Mrows;
            if (sl == 1) {
                M2 = last ? TL : TT_ROWS;
                const int nA = NCHUNK * 4, nPool = last ? 1024 : 1088, nConv = nPool;
#ifndef NO_PASSA
                { PHASE_LOCALS
#pragma unroll 1
                for (int it = blockIdx.x; it < nA; it += G) gla_pass_a(a, l, it >> 2, it & 3, lds, tid, lane, wave); }
#endif
#ifndef NO_POOLCONV
                { PHASE_LOCALS
#pragma unroll 1
                for (int j = ((G & 7) ? (int)blockIdx.x : (int)((blockIdx.x & 7) * (G >> 3) + (blockIdx.x >> 3))); j < nPool; j += G) { if (j < 1024) pool_unit(a, true, j >> 6, j & 63, lds, tid); else pool_unit(a, false, (j - 1024) >> 2, (j - 1024) & 3, lds, tid); } }
                { PHASE_LOCALS
#pragma unroll 1
                for (int j = (((G & 7) ? (int)blockIdx.x : (int)((blockIdx.x & 7) * (G >> 3) + (blockIdx.x >> 3))) + 128) % G; j < nConv; j += G) { if (j < 1024) conv_unit(a, l, (j >> 6) * SEQ, (j & 63) * 64, SEQ, lds, tid, lane, wave); else conv_unit(a, l, TL + ((j - 1024) >> 2) * CTXL, ((j - 1024) & 3) * 64, CTXL, lds, tid, lane, wave); } }
#endif
                GRID_SYNC();
#ifndef NO_SCAN
                { PHASE_LOCALS gla_scan(a, tid, G); }
#endif
                GRID_SYNC();
                const int nC = (last ? 1024 : NCHUNK) * 4;
#ifndef NO_PASSC
                { PHASE_LOCALS
#pragma unroll 1
                for (int it = blockIdx.x; it < nC; it += G) gla_pass_c(a, l, it >> 2, it & 3, lds, tid, lane, wave); }
#endif
                GRID_SYNC();
            }
            { const KArgs a = load_args(); const unsigned char* wl = a.ws + WS_W + (size_t)l * W_LAYER;
              pg8::Gemm g{(const bf16*)(a.ws + (sl == 1 ? WS_H : WS_ACT)), (const bf16*)(wl + (sl == 0 ? WO_DN1 : (sl == 2 ? WO_DN2 : WO_OUT))), M2, D, sl == 1 ? D : DFF};
              pg8::StaticOrder S; S.init(g.M, g.N, G, (int)blockIdx.x);
              pg8::EpiBf16 E{(bf16*)(a.ws + WS_Y), D, 0, sl == 1 ? (const float*)(a.ws + WS_BOUT) + l * D : nullptr};
#ifndef NO_GEMM2
              pg8::gemm_phase<pg8::EpiBf16, pg8::StaticOrder, true, true>((PG8_LAS unsigned char*)lds, g, S, E);
#endif
            }
            GRID_SYNC();
            { PHASE_LOCALS
              float* xlat = a.out; float* xctx = (float*)(a.ws + WS_CTXR); const float* MODS = (const float*)(a.ws + WS_MODS);
              const float* modl = MODS + (size_t)l * 17 * NMOD * D; const float* gains = a.in[I_NORMG] + (size_t)l * 6 * D;
              const bool first = (l == 0 && sl == 0), nxl = (sl == 2);
              const float* modn = nxl ? MODS + (size_t)(l + 1) * 17 * NMOD * D : modl + (3 * (sl + 1)) * D;
              const NormP p{a.in[I_X], a.in[I_CTX], xlat, xctx, (bf16*)(a.ws + WS_XR), first ? 1 : 0, (last && sl == 2) ? 1 : 0,
                            (const bf16*)(a.ws + WS_Y), modl + (3 * sl + 2) * D, (sl == 1) ? 1.0f : 0.5f, gains + (2 * sl + 1) * D, 1,
                            modn, modn + D, nxl ? a.in[I_NORMG] + (size_t)(l + 1) * 6 * D : gains + 2 * (sl + 1) * D, (bf16*)(a.ws + WS_H), !(last && sl == 2), M2};
#ifndef NO_NORM
              norm_phase(p, lane, blockIdx.x * NWAVES + wave, G * NWAVES);
#endif
            }
            if (!(last && sl == 2)) GRID_SYNC();
        }
    }
}

extern "C" void kernel_launch(void* const* d_in, const int* in_sizes, int n_in, void* d_out, int out_size, void* d_ws, size_t ws_size, hipStream_t stream) {
    static int grid_blocks = 0;
    if (grid_blocks == 0) {
        if (n_in != 24 || out_size != TL * D || ws_size < WS_END) { fprintf(stderr, "kernel_launch: unexpected shapes (n_in %d, out %d, ws %zu)\n", n_in, out_size, ws_size); grid_blocks = -1; return; }
        int dev = 0, cus = 0, per_cu = 0;
        hipGetDevice(&dev); hipDeviceGetAttribute(&cus, hipDeviceAttributeMultiprocessorCount, dev);
        if (hipFuncSetAttribute((const void*)fwd_megakernel, hipFuncAttributeMaxDynamicSharedMemorySize, LDS_BYTES) != hipSuccess) { fprintf(stderr, "kernel_launch: hipFuncSetAttribute failed\n"); grid_blocks = -1; return; }
        if (hipOccupancyMaxActiveBlocksPerMultiprocessor(&per_cu, (const void*)fwd_megakernel, NTHREADS, LDS_BYTES) != hipSuccess || per_cu < 1) { fprintf(stderr, "kernel_launch: occupancy query says %d\n", per_cu); per_cu = 1; }
        (void)hipGetLastError();
        grid_blocks = cus * per_cu;
    }
    if (grid_blocks < 0) return;
    if (hipMemsetAsync((char*)d_ws + WS_BAR, 0, BAR_BYTES, stream) != hipSuccess) { fprintf(stderr, "kernel_launch: memset of the barrier words failed\n"); return; }
    KArgs a{};
    for (int i = 0; i < 24; ++i) a.in[i] = (const float*)d_in[i];
    a.out = (float*)d_out; a.ws = (unsigned char*)d_ws;
    void* args[] = {&a};
    hipError_t e = hipLaunchCooperativeKernel((const void*)fwd_megakernel, dim3(grid_blocks), dim3(NTHREADS), args, LDS_BYTES, stream);
    if (e != hipSuccess) fprintf(stderr, "cooperative launch failed: %s (grid %d)\n", hipGetErrorString(e), grid_blocks);
}
```

```cpp
#include <hip/hip_runtime.h>
#include <hip/hip_cooperative_groups.h>
#include <cstdio>
#include <cstdint>
namespace cg = cooperative_groups;
namespace pg8 {
#define PG8_LAS __attribute__((address_space(3)))
typedef unsigned short bf16_t;
typedef short bf16x8 __attribute__((ext_vector_type(8)));
typedef float f32x4 __attribute__((ext_vector_type(4)));
typedef unsigned u32x4 __attribute__((ext_vector_type(4)));
constexpr int BM = 256, BK = 64, HALF = 128, HTB = HALF * BK * 2  , STAGE_BYTES = 8 * HTB, NXCD = 8, WGM = 4;

__host__ __device__ __forceinline__ int lds_byte(int r, int c) { const int st = (r >> 4) * 2 + (c >> 5), rr = r & 15, cc = c & 31, ob = rr * 64 + cc * 2; return st * 1024 + (ob ^ (((ob >> 9) & 1) << 5)); }
__host__ __device__ __forceinline__ void stage_rc(int b, int& R, int& C) { const int st = b / 1024, sb = b % 1024, swz = sb ^ (((sb >> 9) & 1) << 5); R = (st >> 1) * 16 + swz / 64; C = (st & 1) * 32 + (swz % 64) / 2; }
__host__ __device__ __forceinline__ int perm32(int rho) { const int n = rho >> 4, i = rho & 15; return 8 * (i >> 2) + 4 * n + (i & 3); }

struct Unit { int pm, pn; };
struct Gemm { const bf16_t* A; const bf16_t* Bt; int M, N, K; };

struct StaticOrder {
    int nM, nN, nwg, G, c;
    __host__ __device__ void init(int M, int N, int G_, int c_) { nM = M / BM; nN = N / BM; nwg = nM * nN; G = G_; c = c_; }
    __host__ __device__ bool next(int i, Unit& u) const {
        const long L = (long)i * G + c; if (L >= nwg) return false;
        int wgid = (int)L; { const int q = nwg / NXCD, r = nwg % NXCD, xcd = wgid % NXCD, off = wgid / NXCD; wgid = (xcd < r ? xcd * (q + 1) : r * (q + 1) + (xcd - r) * q) + off; }
        const int nig = WGM * nN, gid = wgid / nig, fm = gid * WGM, gsz = (nM - fm) < WGM ? (nM - fm) : WGM;
        u.pm = fm + ((wgid % nig) % gsz); u.pn = (wgid % nig) / gsz; return true;
    }
    __device__ __forceinline__ void a_ready(const Unit&) const {}
    __device__ __forceinline__ void done(const Unit&) const {}
};
__device__ __forceinline__ unsigned cvt_pk_bf16(float lo, float hi) { unsigned r; asm volatile("v_cvt_pk_bf16_f32 %0, %1, %2" : "=v"(r) : "v"(lo), "v"(hi)); return r; }
__device__ __forceinline__ float silu_f(float x) { return x * __builtin_amdgcn_rcpf(1.0f + __expf(-x)); }
struct EpiF32 {
    static constexpr bool PERM = false, AFTER_DRAIN = false;
    float* C; int ldc; const float* bias;
    __device__ __forceinline__ void operator()(const f32x4 (&acc)[2][2][4][2], const Unit& u, int wr, int wc, int fr, int fq) const {
        const int row0 = u.pm * BM + wr * 64 + fr, col0 = u.pn * BM + wc * 32 + 4 * fq;
        f32x4 bv[2][2];
#pragma unroll
        for (int bj = 0; bj < 2; ++bj)
#pragma unroll
            for (int n = 0; n < 2; ++n) bv[bj][n] = bias ? *(const f32x4*)(bias + col0 + bj * HALF + n * 16) : (f32x4){0.f, 0.f, 0.f, 0.f};
#pragma unroll
        for (int ai = 0; ai < 2; ++ai)
#pragma unroll
            for (int m = 0; m < 4; ++m) { float* rowp = C + (size_t)(row0 + ai * HALF + m * 16) * ldc + col0;
#pragma unroll
                for (int bj = 0; bj < 2; ++bj)
#pragma unroll
                    for (int n = 0; n < 2; ++n) *(f32x4*)(rowp + bj * HALF + n * 16) = acc[ai][bj][m][n] + bv[bj][n]; }
    }
};
struct EpiBf16 {
    static constexpr bool PERM = true, AFTER_DRAIN = false;
    bf16_t* O; int ldc; int swiglu; const float* bias;
    __device__ __forceinline__ void operator()(const f32x4 (&acc)[2][2][4][2], const Unit& u, int wr, int wc, int fr, int fq) const {
        const int row0 = u.pm * BM + wr * 64 + fr;
        if (swiglu) {
            const int col0 = u.pn * HALF + wc * 32 + 8 * fq;
#pragma unroll
            for (int ai = 0; ai < 2; ++ai)
#pragma unroll
                for (int m = 0; m < 4; ++m) { bf16_t* rowp = O + (size_t)(row0 + ai * HALF + m * 16) * ldc + col0;
                    const f32x4 a0 = acc[ai][0][m][0], a1 = acc[ai][0][m][1], b0 = acc[ai][1][m][0], b1 = acc[ai][1][m][1];
                    u32x4 w; w.x = cvt_pk_bf16(silu_f(a0[0]) * b0[0], silu_f(a0[1]) * b0[1]); w.y = cvt_pk_bf16(silu_f(a0[2]) * b0[2], silu_f(a0[3]) * b0[3]);
                    w.z = cvt_pk_bf16(silu_f(a1[0]) * b1[0], silu_f(a1[1]) * b1[1]); w.w = cvt_pk_bf16(silu_f(a1[2]) * b1[2], silu_f(a1[3]) * b1[3]);
                    *(u32x4*)rowp = w; }
        } else {
            const int col0 = u.pn * BM + wc * 32 + 8 * fq;
            f32x4 bv[2][2];
#pragma unroll
            for (int bj = 0; bj < 2; ++bj)
#pragma unroll
                for (int n = 0; n < 2; ++n) bv[bj][n] = bias ? *(const f32x4*)(bias + col0 + bj * HALF + 4 * n) : (f32x4){0.f, 0.f, 0.f, 0.f};
#pragma unroll
            for (int ai = 0; ai < 2; ++ai)
#pragma unroll
                for (int m = 0; m < 4; ++m) { bf16_t* rowp = O + (size_t)(row0 + ai * HALF + m * 16) * ldc + col0;
#pragma unroll
                    for (int bj = 0; bj < 2; ++bj) { const f32x4 v0 = acc[ai][bj][m][0] + bv[bj][0], v1 = acc[ai][bj][m][1] + bv[bj][1];
                        u32x4 w; w.x = cvt_pk_bf16(v0[0], v0[1]); w.y = cvt_pk_bf16(v0[2], v0[3]); w.z = cvt_pk_bf16(v1[0], v1[1]); w.w = cvt_pk_bf16(v1[2], v1[3]);
                        *(u32x4*)(rowp + bj * HALF) = w; } }
        }
    }
};

template <class Epi, class Sched, bool ALIGN_EPI = false, bool SP2 = false>
__device__ __forceinline__ void gemm_phase(PG8_LAS unsigned char* lds, const Gemm g, const Sched& S, const Epi& E) {
    int tid_l = threadIdx.x; asm volatile("" : "+v"(tid_l));
    const int tid = tid_l, wid = __builtin_amdgcn_readfirstlane(tid >> 6), lane = tid & 63, wr = wid >> 2, wc = wid & 3, fr = lane & 15, fq = lane >> 4;
    const int K = g.K, nt = K / BK;
    unsigned voffA[2], voffB[2];
#pragma unroll
    for (int i = 0; i < 2; ++i) { int R, C; stage_rc(tid * 16 + i * 8192, R, C); const int Rb = Epi::PERM ? ((R & ~31) + perm32(R & 31)) : R;
        voffA[i] = (unsigned)(R * K + C) * 2u; voffB[i] = (unsigned)(Rb * K + C) * 2u; }
    const size_t kstep = (size_t)(BK * 2);
    const size_t hstep = (size_t)HALF * K * 2;
    const size_t tstep = 2 * hstep;
    const unsigned ldsw = (unsigned)wid * 1024u;
    const int aoff = lds_byte(wr * 64 + fr, fq * 8), boff = lds_byte(wc * 32 + fr, fq * 8);
#define PG8_SA(b, h) (((b) * 2 + (h)) * HTB)
#define PG8_SB(b, h) ((4 + (b) * 2 + (h)) * HTB)
#define PG8_STAGE(bufoff, gbase, voff) do { _Pragma("unroll") for (int _i = 0; _i < 2; ++_i) \
        __builtin_amdgcn_global_load_lds((const unsigned*)((const char*)(gbase) + (voff)[_i]), (PG8_LAS unsigned*)(lds + (bufoff) + ldsw + _i * 8192), 16, 0, 0); } while (0)
#define PG8_LDA(dst, b, h) do { _Pragma("unroll") for (int m = 0; m < 4; ++m) _Pragma("unroll") for (int k = 0; k < 2; ++k) dst[m][k] = *(const PG8_LAS bf16x8*)(lds + PG8_SA(b, h) + aoff + m * 2048 + k * 1024); } while (0)
#define PG8_LDB(dst, b, h) do { _Pragma("unroll") for (int n = 0; n < 2; ++n) _Pragma("unroll") for (int k = 0; k < 2; ++k) dst[n][k] = *(const PG8_LAS bf16x8*)(lds + PG8_SB(b, h) + boff + n * 2048 + k * 1024); } while (0)
#define PG8_MMA(ai, bj, At, Bt) do { __builtin_amdgcn_s_setprio(1); _Pragma("unroll") for (int m = 0; m < 4; ++m) _Pragma("unroll") for (int n = 0; n < 2; ++n) _Pragma("unroll") for (int k = 0; k < 2; ++k) \
        acc[ai][bj][m][n] = __builtin_amdgcn_mfma_f32_16x16x32_bf16(Bt[n][k], At[m][k], acc[ai][bj][m][n], 0, 0, 0); __builtin_amdgcn_s_setprio(0); } while (0)
#define PG8_WAIT_V(n) asm volatile("s_waitcnt vmcnt(" #n ")" ::: "memory")
#define PG8_WAIT_L(n) asm volatile("s_waitcnt lgkmcnt(" #n ")" ::: "memory")
#define PG8_BAR __builtin_amdgcn_s_barrier()
#define PG8_SCHED __builtin_amdgcn_sched_barrier(0)
    Unit cur, nxt; int ui = 0;
    if (!S.next(0, cur)) return;
    f32x4 acc[2][2][4][2];
#pragma unroll
    for (int a = 0; a < 2; ++a)
#pragma unroll
        for (int b = 0; b < 2; ++b)
#pragma unroll
            for (int m = 0; m < 4; ++m)
#pragma unroll
                for (int n = 0; n < 2; ++n) acc[a][b][m][n] = (f32x4){0.f, 0.f, 0.f, 0.f};
    bf16x8 At[4][2], B0[2][2], B1[2][2];
    const char* cA = (const char*)g.A + (size_t)cur.pm * tstep; const char* cB = (const char*)g.Bt + (size_t)cur.pn * tstep;
    S.a_ready(cur);
    if constexpr (SP2) {
        PG8_STAGE(PG8_SB(0, 0), cB, voffB); PG8_STAGE(PG8_SB(0, 1), cB + hstep, voffB); PG8_STAGE(PG8_SA(0, 0), cA, voffA); PG8_STAGE(PG8_SA(0, 1), cA + hstep, voffA);
        if (wr == 1) PG8_BAR;
        PG8_WAIT_V(2); PG8_BAR;
        PG8_STAGE(PG8_SB(1, 0), cB + kstep, voffB); PG8_STAGE(PG8_SA(1, 0), cA + kstep, voffA); PG8_STAGE(PG8_SB(1, 1), cB + hstep + kstep, voffB);
        PG8_WAIT_V(6); PG8_BAR;
    } else {
        PG8_STAGE(PG8_SB(0, 0), cB, voffB); PG8_STAGE(PG8_SA(0, 0), cA, voffA); PG8_STAGE(PG8_SB(0, 1), cB + hstep, voffB); PG8_STAGE(PG8_SA(0, 1), cA + hstep, voffA);
        if (wr == 1) PG8_BAR;
        PG8_WAIT_V(4); PG8_BAR;
        PG8_STAGE(PG8_SB(1, 0), cB + kstep, voffB); PG8_STAGE(PG8_SA(1, 0), cA + kstep, voffA); PG8_STAGE(PG8_SB(1, 1), cB + hstep + kstep, voffB);
        PG8_WAIT_V(6); PG8_BAR;
    }
    for (;;) {
        const bool has_next = S.next(ui + 1, nxt);
        const char* nA = has_next ? (const char*)g.A + (size_t)nxt.pm * tstep : cA; const char* nB = has_next ? (const char*)g.Bt + (size_t)nxt.pn * tstep : cB;
        for (int t = 0; t < nt; t += 2) {
            const bool last = (t == nt - 2);
            const char* a1 = cA + (size_t)(t + 1) * kstep;
            const char* a2 = last ? nA : cA + (size_t)(t + 2) * kstep; const char* b2 = last ? nB : cB + (size_t)(t + 2) * kstep;
            const char* a3 = a2 + kstep; const char* b3 = b2 + kstep;
            if (last && has_next) S.a_ready(nxt);
            if constexpr (SP2) {
            PG8_LDB(B0, 0, 0); PG8_LDB(B1, 0, 1); PG8_SCHED; PG8_LDA(At, 0, 0); PG8_STAGE(PG8_SA(1, 1), a1 + hstep, voffA);
            PG8_WAIT_V(8); PG8_WAIT_L(0); PG8_BAR; PG8_MMA(0, 0, At, B0); PG8_MMA(0, 1, At, B1); PG8_BAR; PG8_SCHED;
            PG8_LDA(At, 0, 1); PG8_STAGE(PG8_SB(0, 0), b2, voffB); PG8_STAGE(PG8_SB(0, 1), b2 + hstep, voffB); PG8_STAGE(PG8_SA(0, 0), a2, voffA);
            PG8_WAIT_V(8); PG8_WAIT_L(0); PG8_BAR; PG8_MMA(1, 0, At, B0); PG8_MMA(1, 1, At, B1); PG8_BAR; PG8_SCHED;
            PG8_LDB(B0, 1, 0); PG8_LDB(B1, 1, 1); PG8_SCHED; PG8_LDA(At, 1, 0); PG8_STAGE(PG8_SA(0, 1), a2 + hstep, voffA);
            PG8_WAIT_V(8); PG8_WAIT_L(0); PG8_BAR; PG8_MMA(0, 0, At, B0); PG8_MMA(0, 1, At, B1); PG8_BAR; PG8_SCHED;
            PG8_LDA(At, 1, 1); PG8_STAGE(PG8_SB(1, 0), b3, voffB); PG8_STAGE(PG8_SB(1, 1), b3 + hstep, voffB); PG8_STAGE(PG8_SA(1, 0), a3, voffA);
            PG8_WAIT_V(8); PG8_WAIT_L(0); PG8_BAR; PG8_MMA(1, 0, At, B0); PG8_MMA(1, 1, At, B1); PG8_BAR; PG8_SCHED;
            } else {
            PG8_LDB(B0, 0, 0); PG8_SCHED; PG8_LDA(At, 0, 0); PG8_STAGE(PG8_SA(1, 1), a1 + hstep, voffA);
            PG8_WAIT_L(8); PG8_BAR; PG8_WAIT_L(0); PG8_MMA(0, 0, At, B0); PG8_BAR; PG8_SCHED;
            PG8_LDB(B1, 0, 1); PG8_STAGE(PG8_SB(0, 0), b2, voffB);
            PG8_BAR; PG8_WAIT_L(0); PG8_MMA(0, 1, At, B1); PG8_BAR;
            PG8_LDA(At, 0, 1); PG8_STAGE(PG8_SA(0, 0), a2, voffA);
            PG8_BAR; PG8_WAIT_L(0); PG8_MMA(1, 0, At, B0); PG8_BAR; PG8_SCHED;
            PG8_STAGE(PG8_SB(0, 1), b2 + hstep, voffB);
            PG8_WAIT_V(6); PG8_BAR; PG8_MMA(1, 1, At, B1); PG8_BAR;
            PG8_LDB(B0, 1, 0); PG8_SCHED; PG8_LDA(At, 1, 0); PG8_STAGE(PG8_SA(0, 1), a2 + hstep, voffA);
            PG8_WAIT_L(8); PG8_BAR; PG8_WAIT_L(0); PG8_MMA(0, 0, At, B0); PG8_BAR; PG8_SCHED;
            PG8_LDB(B1, 1, 1); PG8_STAGE(PG8_SB(1, 0), b3, voffB);
            PG8_BAR; PG8_WAIT_L(0); PG8_MMA(0, 1, At, B1); PG8_BAR;
            PG8_LDA(At, 1, 1); PG8_STAGE(PG8_SA(1, 0), a3, voffA);
            PG8_BAR; PG8_WAIT_L(0); PG8_MMA(1, 0, At, B0); PG8_BAR; PG8_SCHED;
            PG8_STAGE(PG8_SB(1, 1), b3 + hstep, voffB);
            PG8_WAIT_V(6); PG8_BAR; PG8_MMA(1, 1, At, B1); PG8_BAR;
            }
        }
        if constexpr (ALIGN_EPI) { if (wr == 0) PG8_BAR; }
        if constexpr (!Epi::AFTER_DRAIN) { E(acc, cur, wr, wc, fr, fq); S.done(cur); }
        if (!has_next) break;
#pragma unroll
        for (int a = 0; a < 2; ++a)
#pragma unroll
            for (int b = 0; b < 2; ++b)
#pragma unroll
                for (int m = 0; m < 4; ++m)
#pragma unroll
                    for (int n = 0; n < 2; ++n) acc[a][b][m][n] = (f32x4){0.f, 0.f, 0.f, 0.f};
        cur = nxt; cA = nA; cB = nB; ++ui;
        if constexpr (ALIGN_EPI) { if (wr == 1) PG8_BAR; }
    }
    PG8_WAIT_V(0);
    if constexpr (!ALIGN_EPI) { if (wr == 0) PG8_BAR; }
    PG8_BAR;
    if constexpr (Epi::AFTER_DRAIN) { E.fused(acc, cur, wr, wc, fr, fq, lds, wid, lane); S.done(cur); }
#undef PG8_SA
#undef PG8_SB
#undef PG8_STAGE
#undef PG8_LDA
#undef PG8_LDB
#undef PG8_MMA
#undef PG8_WAIT_V
#undef PG8_WAIT_L
#undef PG8_BAR
#undef PG8_SCHED
}
}

constexpr int D = 1024, NBATCH = 16, SEQ = 4096, CTXL = 256, TL = NBATCH * SEQ, TC = NBATCH * CTXL, TT_ROWS = TL + TC;
constexpr int DFF = 2816, NUP = 2 * DFF, DIN = 2336, NIN = 2560, NMOD = 9;
constexpr int NCHUNK = TT_ROWS / 64;
constexpr int PSTR = NIN;
constexpr int PC_Q = 0, PC_K = 256, PC_V = 512, PC_G = 1024, PC_POOL = 1536, PC_CA = 1792, PC_CG = 2048, PC_LR = 2304;
constexpr float EPS = 1e-6f;
constexpr int NWAVES = 8, NTHREADS = 512;
constexpr int LDS_BYTES = 163840;

constexpr size_t MiB = 1u << 20;
constexpr size_t WS_MODS = 0;
constexpr size_t WS_BOUT = WS_MODS + (size_t)1536 * 1024;
constexpr size_t WS_BAR = (size_t)1792 * 1024, BAR_BYTES = 16384;
constexpr size_t WS_W = 2 * MiB, W_LAYER = 40 * MiB;
constexpr size_t WO_UP1 = 0, WO_DN1 = 11 * MiB, WO_UP2 = 33 * MiB / 2, WO_DN2 = 55 * MiB / 2, WO_IN = 33 * MiB, WO_OUT = 38 * MiB;
constexpr size_t WS_CTXR = 82 * MiB;
constexpr size_t WS_H = 98 * MiB;
constexpr size_t WS_ACT = 234 * MiB;
constexpr size_t WS_Y = 608 * MiB;
constexpr size_t WS_DC = 880 * MiB;
constexpr size_t WS_XR = 884 * MiB;
constexpr size_t WS_END = 1020 * MiB;

typedef unsigned short bf16;
typedef float f32x4 __attribute__((ext_vector_type(4)));
typedef short bf16x8 __attribute__((ext_vector_type(8)));
typedef unsigned u32x4v __attribute__((ext_vector_type(4)));
typedef unsigned u32x2v __attribute__((ext_vector_type(2)));

typedef __bf16 bf16x2n __attribute__((ext_vector_type(2)));
typedef float f32x2n __attribute__((ext_vector_type(2)));
__device__ __forceinline__ unsigned f2bf(float f) { return (unsigned)__builtin_bit_cast(unsigned short, (__bf16)f); }
__device__ __forceinline__ unsigned pk2(float lo, float hi) { const f32x2n v = {lo, hi}; return __builtin_bit_cast(unsigned, __builtin_convertvector(v, bf16x2n)); }
__device__ __forceinline__ float bflo(unsigned w) { return __builtin_bit_cast(float, w << 16); }
__device__ __forceinline__ float bfhi(unsigned w) { return __builtin_bit_cast(float, w & 0xffff0000u); }
__device__ __forceinline__ float bf2f(bf16 b) { return __builtin_bit_cast(float, (unsigned)b << 16); }
__device__ __forceinline__ float wave_sum(float v) {
#pragma unroll
    for (int o = 1; o < 64; o <<= 1) v += __shfl_xor(v, o);
    return v;
}
__device__ __forceinline__ float sigmoid_f(float x) { return __builtin_amdgcn_rcpf(1.0f + __expf(-x)); }
__device__ __forceinline__ float silu(float x) { return x * sigmoid_f(x); }
__device__ __forceinline__ float logsigmoid_f(float x) { return fminf(x, 0.f) - __logf(1.0f + __expf(-fabsf(x))); }
__device__ __forceinline__ void unpack8(const u32x4v r, float (&f)[8]) { f[0] = bflo(r.x); f[1] = bfhi(r.x); f[2] = bflo(r.y); f[3] = bfhi(r.y); f[4] = bflo(r.z); f[5] = bfhi(r.z); f[6] = bflo(r.w); f[7] = bfhi(r.w); }

struct KArgs { const float* in[24]; float* out; unsigned char* ws; };
enum { I_X = 0, I_C, I_CTX, I_CCTX, I_WADA, I_BADA, I_NORMG, I_F1UP, I_F1DN, I_F2UP, I_F2DN, I_WIN, I_WGK2, I_BGK, I_GLAG, I_POOLW, I_POOLS, I_CDW, I_CDWB, I_CLNG, I_CLNB, I_CPW, I_CPWB, I_WOUT };

#define LAS __attribute__((address_space(3)))
#define XB_TMO      128
#define XB_XCNT(j)  (256  + 64 * (j))
#define XB_XSUB(j)  (1280 + 64 * (j))
#define XB_XGEN(j)  (2304 + 64 * (j))
#define XB_TOP      3328
#define XB_TOPGEN   3392
#define XCD_BAR_WORDS 3456
#define XB_SPIN_CAP (1u << 18)

__device__ __forceinline__ unsigned xb_ld(unsigned* p)              { return __hip_atomic_load(p, __ATOMIC_RELAXED, __HIP_MEMORY_SCOPE_AGENT); }
__device__ __forceinline__ unsigned xb_add(unsigned* p, unsigned v) { return __hip_atomic_fetch_add(p, v, __ATOMIC_RELAXED, __HIP_MEMORY_SCOPE_AGENT); }
__device__ __forceinline__ unsigned xb_xcc_id() { return (unsigned)__builtin_amdgcn_s_getreg((3 << 11) | 20) & 0xFu; }
#define XB_SPIN(cond, bar) do { unsigned _sp = 0; while (cond) { __builtin_amdgcn_s_sleep(1); \
    if ((++_sp & 255u) == 0u) { if (xb_ld(&(bar)[XB_TMO])) break; if (_sp > XB_SPIN_CAP) { atomicAdd(&(bar)[XB_TMO], 1u); break; } } } } while (0)

struct XcdBarrier {
    unsigned* bar; unsigned x;
    volatile LAS unsigned* st;
};

__device__ __forceinline__ XcdBarrier xcd_barrier_post(unsigned* bar, volatile LAS unsigned* st) {
    XcdBarrier b; b.bar = bar; b.x = xb_xcc_id(); b.st = st;
    if (threadIdx.x == 0) (void)xb_add(&bar[XB_XCNT(b.x)], 1u);
    return b;
}
__device__ __forceinline__ void xcd_barrier_complete(unsigned* bar, unsigned x, unsigned& nloc, unsigned& nx) {
    const unsigned G = gridDim.x * gridDim.y * gridDim.z;
    unsigned sum, cnt, mine, sp = 0u;
    for (;;) {
        sum = 0u; cnt = 0u; mine = 0u;
#pragma unroll
        for (unsigned j = 0; j < 16; ++j) { const unsigned c = xb_ld(&bar[XB_XCNT(j)]); sum += c; cnt += (c > 0u) ? 1u : 0u; mine = (j == x) ? c : mine; }
        if (sum == G) break;
        __builtin_amdgcn_s_sleep(1);
        if ((++sp & 255u) == 0u) { if (xb_ld(&bar[XB_TMO])) break; if (sp > XB_SPIN_CAP) { atomicAdd(&bar[XB_TMO], 1u); break; } }
    }
    nloc = mine > 0u ? mine : 1u; nx = cnt > 0u ? cnt : 1u;
}

__device__ __forceinline__ void xcd_barrier(const XcdBarrier& b) {
    asm volatile("s_waitcnt vmcnt(0)" ::: "memory");
    __syncthreads();
    if (threadIdx.x == 0) {
        unsigned* bar = b.bar;
        __builtin_amdgcn_s_waitcnt(0);
        unsigned nloc = b.st[0], nx = b.st[1];
        if (nloc == 0u) { xcd_barrier_complete(bar, b.x, nloc, nx); b.st[0] = nloc; b.st[1] = nx; }
        const unsigned old = xb_add(&bar[XB_XSUB(b.x)], 1u);
        const unsigned gen = old / nloc;
        if (old + 1u == (gen + 1u) * nloc) {
            __builtin_amdgcn_fence(__ATOMIC_RELEASE, "agent");
            asm volatile("s_waitcnt vmcnt(0)" ::: "memory");
            const unsigned og = xb_add(&bar[XB_TOP], 1u);
            const unsigned tg = og / nx;
            if (og + 1u == (tg + 1u) * nx) xb_add(&bar[XB_TOPGEN], 1u);
            else XB_SPIN(xb_ld(&bar[XB_TOPGEN]) == tg, bar);
            __builtin_amdgcn_fence(__ATOMIC_ACQUIRE, "agent");
            xb_add(&bar[XB_XGEN(b.x)], 1u);
            asm volatile("s_waitcnt vmcnt(0)" ::: "memory");
        } else {
            XB_SPIN(xb_ld(&bar[XB_XGEN(b.x)]) == gen, bar);
            __builtin_amdgcn_fence(__ATOMIC_ACQUIRE, "agent");
            asm volatile("s_waitcnt vmcnt(0)" ::: "memory");
        }
    }
    __syncthreads();
}

typedef const KArgs __attribute__((address_space(4)))* KArgsP;
__device__ __forceinline__ KArgs load_args() {
    KArgsP p = (KArgsP)__builtin_amdgcn_kernarg_segment_ptr(); asm volatile("" : "+s"(p));
    KArgs a;
#pragma unroll
    for (int i = 0; i < 24; ++i) a.in[i] = p->in[i];
    a.out = p->out; a.ws = p->ws; return a;
}
__device__ __forceinline__ int opaque_tid() { int t = threadIdx.x; asm volatile("" : "+v"(t)); return t; }
#define PHASE_LOCALS const KArgs a = load_args(); const int tid = opaque_tid(), lane = tid & 63, wave = __builtin_amdgcn_readfirstlane(tid >> 6); (void)lane; (void)wave;

__device__ __forceinline__ void tr_item(const float* W, int ldw, int col0, bf16* WT, int ldt, int drow0, int k0, float* scr, int lane, bool zero) {
#pragma unroll
    for (int i = 0; i < 32; ++i) { const int kk = 2 * i + (lane >> 5); scr[kk * 33 + (lane & 31)] = zero ? 0.f : W[(size_t)(k0 + kk) * ldw + col0 + (lane & 31)]; }
    asm volatile("s_waitcnt lgkmcnt(0)" ::: "memory");
    const int c = lane & 7;
#pragma unroll
    for (int j = 0; j < 4; ++j) { const int n = (lane >> 3) + 8 * j; const float* s = scr + (8 * c) * 33 + n;
        u32x4v o; o.x = pk2(s[0 * 33], s[1 * 33]); o.y = pk2(s[2 * 33], s[3 * 33]); o.z = pk2(s[4 * 33], s[5 * 33]); o.w = pk2(s[6 * 33], s[7 * 33]);
        *(u32x4v*)(WT + (size_t)(drow0 + n) * ldt + k0 + 8 * c) = o; }
    asm volatile("s_waitcnt lgkmcnt(0)" ::: "memory");
}

__device__ __forceinline__ void prep_phase(const KArgs& a, unsigned char* lds, int tid, int lane, int wave, int G) {
    float* scr = (float*)(lds + wave * 16384);
    const int gw = blockIdx.x * NWAVES + wave, NGW = G * NWAVES;
    constexpr int I_UP = 16 * 176, I_DN = 44 * 32, I_IN = 16 * 80, I_OT = 8 * 32, I_LAYER = 2 * I_UP + 2 * I_DN + I_IN + I_OT;
    for (int it = gw; it < 2 * I_LAYER; it += NGW) {
        const int l = it / I_LAYER; int r = it % I_LAYER;
        unsigned char* wl = a.ws + WS_W + (size_t)l * W_LAYER;
        if (r < 2 * I_UP) { const int f = r / I_UP; r %= I_UP; const int kb = r / 176, db = r % 176;
            const int tile = db >> 3, half = (db >> 2) & 1, q = db & 3;
            tr_item((f ? a.in[I_F2UP] : a.in[I_F1UP]) + (size_t)l * D * NUP, NUP, half * DFF + tile * 128 + q * 32, (bf16*)(wl + (f ? WO_UP2 : WO_UP1)), D, db * 32, kb * 64, scr, lane, false); continue; }
        r -= 2 * I_UP;
        if (r < 2 * I_DN) { const int f = r / I_DN; r %= I_DN; const int kb = r / 32, db = r % 32;
            tr_item((f ? a.in[I_F2DN] : a.in[I_F1DN]) + (size_t)l * DFF * D, D, db * 32, (bf16*)(wl + (f ? WO_DN2 : WO_DN1)), DFF, db * 32, kb * 64, scr, lane, false); continue; }
        r -= 2 * I_DN;
        if (r < I_IN) { const int kb = r / 80, db = r % 80;
            const int src = db < 48 ? db * 32 : (db < 72 ? db * 32 + 32 : 1536);
            tr_item(a.in[I_WIN] + (size_t)l * D * DIN, DIN, src, (bf16*)(wl + WO_IN), D, db * 32, kb * 64, scr, lane, db > 72); continue; }
        r -= I_IN;
        { const int kb = r / 32, db = r % 32;
          tr_item(a.in[I_WOUT] + (size_t)l * D * D, D, db * 32, (bf16*)(wl + WO_OUT), D, db * 32, kb * 64, scr, lane, false); }
    }
    for (int e = blockIdx.x * NTHREADS + tid; e < 2 * 64 * 1024; e += G * NTHREADS) {
        const int n = e & 1023, kg = (e >> 10) & 63, l = e >> 16, k0 = 512 + 8 * kg;
        const float* wo = a.in[I_WOUT] + (size_t)l * D * D;
        float acc[8];
#pragma unroll
        for (int q = 0; q < 8; ++q) acc[q] = 0.f;
        if (k0 < 768) { const int gi = (k0 - 512) >> 6, i0 = (k0 - 512) & 63;
            const float* pw = a.in[I_POOLW] + ((size_t)(l * 4 + gi) * 64 + i0) * 64; const float* sc = a.in[I_POOLS] + l * 256 + gi * 64;
            for (int j0 = 0; j0 < 64; j0 += 16) { float w[16];
#pragma unroll
                for (int jj = 0; jj < 16; ++jj) w[jj] = wo[(size_t)(512 + gi * 64 + j0 + jj) * D + n];
#pragma unroll
                for (int jj = 0; jj < 16; ++jj) { const float ws = w[jj] * sc[j0 + jj];
#pragma unroll
                    for (int q = 0; q < 8; ++q) acc[q] += pw[q * 64 + j0 + jj] * ws; } }
        } else { const int i0 = k0 - 768; const float* pw = a.in[I_CPW] + ((size_t)l * 256 + i0) * 256;
            for (int j0 = 0; j0 < 256; j0 += 16) { float w[16];
#pragma unroll
                for (int jj = 0; jj < 16; ++jj) w[jj] = wo[(size_t)(768 + j0 + jj) * D + n];
#pragma unroll
                for (int jj = 0; jj < 16; ++jj) {
#pragma unroll
                    for (int q = 0; q < 8; ++q) acc[q] += pw[q * 256 + j0 + jj] * w[jj]; } }
        }
        u32x4v o; o.x = pk2(acc[0], acc[1]); o.y = pk2(acc[2], acc[3]); o.z = pk2(acc[4], acc[5]); o.w = pk2(acc[6], acc[7]);
        *(u32x4v*)((bf16*)(a.ws + WS_W + (size_t)l * W_LAYER + WO_OUT) + (size_t)n * D + k0) = o;
    }
    for (int e = blockIdx.x * NTHREADS + tid; e < 2 * 1024; e += G * NTHREADS) {
        const int n = e & 1023, l = e >> 10; const float* wo = a.in[I_WOUT] + (size_t)l * D * D; const float* pb = a.in[I_CPWB] + l * 256;
        float s = 0.f;
        for (int j0 = 0; j0 < 256; j0 += 16) { float w[16];
#pragma unroll
            for (int jj = 0; jj < 16; ++jj) w[jj] = wo[(size_t)(768 + j0 + jj) * D + n];
#pragma unroll
            for (int jj = 0; jj < 16; ++jj) s += pb[j0 + jj] * w[jj]; }
        ((float*)(a.ws + WS_BOUT))[e] = s;
    }
    __syncthreads();
    float* sc = (float*)lds;
    float* red = (float*)(lds + 17 * 4096);
    for (int e = tid; e < 17 * 1024; e += NTHREADS) { const float v = e < 16 * 1024 ? a.in[I_C][e] : a.in[I_CCTX][e - 16 * 1024]; sc[e] = silu(v); }
    __syncthreads();
    for (int it = blockIdx.x; it < 2 * 288; it += G) {
        const int l = it / 288, n0 = (it % 288) * 32, col = tid & 31, ks = tid >> 5;
        const float* w = a.in[I_WADA] + (size_t)l * D * (NMOD * D) + n0 + col;
        float acc[17];
#pragma unroll
        for (int r = 0; r < 17; ++r) acc[r] = 0.f;
        for (int k0 = ks * 64; k0 < ks * 64 + 64; k0 += 16) { float wv[16];
#pragma unroll
            for (int kk = 0; kk < 16; ++kk) wv[kk] = w[(size_t)(k0 + kk) * (NMOD * D)];
#pragma unroll
            for (int kk = 0; kk < 16; ++kk) {
#pragma unroll
                for (int r = 0; r < 17; ++r) acc[r] += sc[r * 1024 + k0 + kk] * wv[kk]; } }
#pragma unroll
        for (int r = 0; r < 17; ++r) red[(ks * 17 + r) * 32 + col] = acc[r];
        __syncthreads();
        for (int e = tid; e < 17 * 32; e += NTHREADS) { const int r = e >> 5, c2 = e & 31; float s = a.in[I_BADA][l * NMOD * D + n0 + c2];
            for (int q = 0; q < 16; ++q) s += red[(q * 17 + r) * 32 + c2];
            ((float*)(a.ws + WS_MODS))[((size_t)l * 17 + r) * (NMOD * D) + n0 + c2] = s; }
        __syncthreads();
    }
}

struct NormP {
    const float* xin_lat; const float* xin_ctx; float* xout_lat; float* xout_ctx;
    bf16* xr; int x_f32, out_f32;
    const bf16* Y; const float* gate; float w; const float* g_post; int has_y;
    const float* shift; const float* scale; const float* g_pre; bf16* H; int has_next; int nrows;
};
__device__ __forceinline__ float sumsq4(const f32x4 (&v)[4]) { float ss = 0.f;
#pragma unroll
    for (int j = 0; j < 4; ++j) ss += (v[j].x * v[j].x + v[j].y * v[j].y) + (v[j].z * v[j].z + v[j].w * v[j].w);
    return ss; }
struct NormVec { f32x4 vA[4], vB[4], vS[4]; int cur_b; };
__device__ __forceinline__ void norm_load(const NormP& p, int r, int lane, f32x4 (&x)[4], u32x2v (&y)[4]) {
    if (p.x_f32) { const float* xr = r < TL ? p.xin_lat + (size_t)r * D : p.xin_ctx + (size_t)(r - TL) * D;
#pragma unroll
        for (int j = 0; j < 4; ++j) x[j] = __builtin_nontemporal_load((const f32x4*)xr + lane + 64 * j); }
    else {
#pragma unroll
        for (int j = 0; j < 4; ++j) { const u32x2v t = __builtin_nontemporal_load((const u32x2v*)(p.xr + (size_t)r * D) + lane + 64 * j); x[j] = (f32x4){bflo(t.x), bfhi(t.x), bflo(t.y), bfhi(t.y)}; } }
    if (p.has_y) {
#pragma unroll
        for (int j = 0; j < 4; ++j) y[j] = __builtin_nontemporal_load((const u32x2v*)(p.Y + (size_t)r * D) + lane + 64 * j); }
}
__device__ __forceinline__ void norm_row(const NormP& p, int r, int lane, f32x4 (&v)[4], const u32x2v (&yr)[4], NormVec& c) {
    const int b = r < TL ? (r >> 12) : 16;
    if (b != c.cur_b) { c.cur_b = b;
        if (p.has_y) { const f32x4* gt = (const f32x4*)(p.gate + (size_t)b * (NMOD * D)); const f32x4* gp = (const f32x4*)p.g_post;
#pragma unroll
            for (int j = 0; j < 4; ++j) c.vA[j] = gt[lane + 64 * j] * gp[lane + 64 * j] * p.w; }
        if (p.has_next) { const f32x4* sh = (const f32x4*)(p.shift + (size_t)b * (NMOD * D)); const f32x4* sc = (const f32x4*)(p.scale + (size_t)b * (NMOD * D)); const f32x4* gp = (const f32x4*)p.g_pre;
#pragma unroll
            for (int j = 0; j < 4; ++j) { c.vB[j] = gp[lane + 64 * j] * (sc[lane + 64 * j] + 1.0f); c.vS[j] = sh[lane + 64 * j]; } } }
    if (p.has_y) {
        f32x4 y[4];
#pragma unroll
        for (int j = 0; j < 4; ++j) y[j] = (f32x4){bflo(yr[j].x), bfhi(yr[j].x), bflo(yr[j].y), bfhi(yr[j].y)};
        const float rs = rsqrtf(wave_sum(sumsq4(y)) * (1.f / D) + EPS);
#pragma unroll
        for (int j = 0; j < 4; ++j) v[j] = v[j] + c.vA[j] * (y[j] * rs);
        if (p.out_f32) {
#pragma unroll
            for (int j = 0; j < 4; ++j) __builtin_nontemporal_store(v[j], (f32x4*)(p.xout_lat + (size_t)r * D) + lane + 64 * j); }
        else {
#pragma unroll
            for (int j = 0; j < 4; ++j) { u32x2v o; o.x = pk2(v[j].x, v[j].y); o.y = pk2(v[j].z, v[j].w); __builtin_nontemporal_store(o, (u32x2v*)(p.xr + (size_t)r * D) + lane + 64 * j); } }
    }
    if (p.has_next) {
        const float rs = rsqrtf(wave_sum(sumsq4(v)) * (1.f / D) + EPS);
        u32x2v* ho = (u32x2v*)(p.H + (size_t)r * D);
#pragma unroll
        for (int j = 0; j < 4; ++j) { const f32x4 h = v[j] * rs * c.vB[j] + c.vS[j];
            u32x2v o; o.x = pk2(h.x, h.y); o.y = pk2(h.z, h.w); ho[lane + 64 * j] = o; }
    }
}
__device__ __forceinline__ void norm_phase(const NormP& p, int lane, int gw, int NGW) {
    const int rpw = p.nrows / NGW, rbeg = gw * rpw, rend = rbeg + rpw;
    NormVec c; c.cur_b = -1;
    f32x4 xa[4], xb[4], v[4]; u32x2v ya[4], yb[4], yv[4];
    norm_load(p, rbeg, lane, xa, ya); norm_load(p, rbeg + 1, lane, xb, yb);
#pragma unroll 1
    for (int r = rbeg; r < rend; r += 2) {
#pragma unroll
        for (int j = 0; j < 4; ++j) { v[j] = xa[j]; yv[j] = ya[j]; }
        norm_load(p, min(r + 2, rend - 1), lane, xa, ya);
        norm_row(p, r, lane, v, yv, c);
#pragma unroll
        for (int j = 0; j < 4; ++j) { v[j] = xb[j]; yv[j] = yb[j]; }
        norm_load(p, min(r + 3, rend - 1), lane, xb, yb);
        norm_row(p, r + 1, lane, v, yv, c);
    }
}

constexpr int GL_G = 0, GL_ATT = 0, GL_LR = 32768, GL_SEG = 40960, GL_TT = 43008, GL_SS = 43520, GL_QT = 44032, GL_KA = 62464, GL_VT = 80896, GL_SB = 99328;
constexpr int RP = 72;
__device__ __forceinline__ int swz_off(int row, int tok) { return row * 64 + ((((tok >> 3) ^ row ^ (row >> 3)) & 7) << 3) + (tok & 7); }

__device__ __forceinline__ void gla_gk(const bf16* P, int row0, int h, const float* w2, const float* bgk, unsigned char* lds, int tid) {
    float* LR = (float*)(lds + GL_LR); float* SEG = (float*)(lds + GL_SEG); float* TT = (float*)(lds + GL_TT); float* G = (float*)(lds + GL_G);
    { const int tok = tid >> 3, c4 = (tid & 7) * 4; const u32x2v raw = *(const u32x2v*)(P + (size_t)(row0 + tok) * PSTR + PC_LR + c4);
      LR[tok * 32 + c4 + 0] = bflo(raw.x); LR[tok * 32 + c4 + 1] = bfhi(raw.x); LR[tok * 32 + c4 + 2] = bflo(raw.y); LR[tok * 32 + c4 + 3] = bfhi(raw.y); }
    const int d = tid >> 8, tq = (tid >> 6) & 3, k = tid & 63;
    float w[16];
#pragma unroll
    for (int r = 0; r < 16; ++r) w[r] = w2[(d * 16 + r) * 256 + h * 64 + k];
    const float bias = bgk[d * 256 + h * 64 + k];
    __syncthreads();
    float p[16]; float run = 0.f;
#pragma unroll
    for (int i = 0; i < 16; ++i) { const float* lr = LR + (16 * tq + i) * 32 + d * 16; float logit = bias;
#pragma unroll
        for (int r = 0; r < 16; ++r) logit += lr[r] * w[r];
        const float gk = logsigmoid_f(logit) * (1.0f / 16.0f);
        if (d == 0) { run += gk; p[i] = run; } else { p[i] = run; run += gk; } }
    SEG[(d * 4 + tq) * 64 + k] = run;
    __syncthreads();
    float off = 0.f, tot = 0.f;
#pragma unroll
    for (int q = 0; q < 4; ++q) { const float s = SEG[(d * 4 + q) * 64 + k]; tot += s; if (q < tq) off += s; }
#pragma unroll
    for (int i = 0; i < 16; ++i) G[(d * 64 + 16 * tq + i) * 64 + k] = p[i] + off;
    if (tq == 0) TT[d * 64 + k] = tot;
    __syncthreads();
}
__device__ __forceinline__ void gla_load_v(const bf16* P, int row0, int h, int tid, u32x4v (&raw)[2]) {
#pragma unroll
    for (int rep = 0; rep < 2; ++rep) { const int idx = tid + rep * NTHREADS, tok = idx >> 4, vg = idx & 15; raw[rep] = *(const u32x4v*)(P + (size_t)(row0 + tok) * PSTR + PC_V + h * 128 + vg * 8); }
}
__device__ __forceinline__ void gla_store_vt(const u32x4v (&rawv)[2], unsigned char* lds, int tid) {
    bf16* VT = (bf16*)(lds + GL_VT);
#pragma unroll
    for (int rep = 0; rep < 2; ++rep) { const int idx = tid + rep * NTHREADS, tok = idx >> 4, vg = idx & 15; const u32x4v raw = rawv[rep];
        const unsigned wv[4] = {raw.x, raw.y, raw.z, raw.w};
#pragma unroll
        for (int q = 0; q < 8; ++q) VT[swz_off(vg * 8 + q, tok)] = (bf16)((q & 1) ? (wv[q >> 1] >> 16) : (wv[q >> 1] & 0xffff)); }
}
#define FRAG(base, row, kk) (*(const bf16x8*)((base) + ((row) + fr) * RP + (kk) * 32 + fq * 8))
#define FRAGS(base, row, kk) (*(const bf16x8*)((base) + swz_off((row) + fr, (kk) * 32 + fq * 8)))

__device__ __forceinline__ void gla_pass_a(const KArgs& a, int l, int cid, int h, unsigned char* lds, int tid, int lane, int wave) {
    const bf16* P = (const bf16*)(a.ws + WS_ACT); const int row0 = cid * 64, u = cid * 4 + h;
    const u32x4v kraw = *(const u32x4v*)(P + (size_t)(row0 + (tid >> 3)) * PSTR + PC_K + h * 64 + (tid & 7) * 8); u32x4v vraw[2]; gla_load_v(P, row0, h, tid, vraw);
    gla_gk(P, row0, h, a.in[I_WGK2] + (size_t)l * 2 * 16 * 256, a.in[I_BGK] + l * 2 * 256, lds, tid);
    const float* G = (const float*)(lds + GL_G); const float* TT = (const float*)(lds + GL_TT);
    bf16* KT = (bf16*)(lds + GL_QT);
    { const int tok = tid >> 3, kg = tid & 7; float kv[8]; unpack8(kraw, kv);
#pragma unroll
      for (int q = 0; q < 8; ++q) { const int kc = kg * 8 + q; const float a0 = G[tok * 64 + kc], a1 = G[(64 + tok) * 64 + kc];
          KT[swz_off(kc, tok)] = (bf16)f2bf(kv[q] * __expf(TT[kc] - a0)); KT[64 * 64 + swz_off(kc, tok)] = (bf16)f2bf(kv[q] * __expf(a1)); } }
    gla_store_vt(vraw, lds, tid);
    if (tid < 128) ((float*)(a.ws + WS_DC))[(size_t)(u * 2 + (tid >> 6)) * 64 + (tid & 63)] = __expf(TT[tid]);
    __syncthreads();
    const int fr = lane & 15, fq = lane >> 4, d = wave >> 2, kt = wave & 3;
    const bf16* VT = (const bf16*)(lds + GL_VT); const bf16* KTd = KT + d * 64 * 64;
    const bf16x8 b0 = FRAGS(KTd, kt * 16, 0), b1 = FRAGS(KTd, kt * 16, 1);
    bf16* ST = (bf16*)(a.ws + WS_Y) + (size_t)(u * 2 + d) * 8192;
#pragma unroll
    for (int vt = 0; vt < 8; ++vt) { f32x4 c = {0.f, 0.f, 0.f, 0.f};
        c = __builtin_amdgcn_mfma_f32_16x16x32_bf16(b0, FRAGS(VT, vt * 16, 0), c, 0, 0, 0);
        c = __builtin_amdgcn_mfma_f32_16x16x32_bf16(b1, FRAGS(VT, vt * 16, 1), c, 0, 0, 0);
        u32x2v o; o.x = pk2(c[0], c[1]); o.y = pk2(c[2], c[3]); *(u32x2v*)(ST + (vt * 16 + fr) * 64 + kt * 16 + fq * 4) = o; }
    __syncthreads();
}

__device__ __forceinline__ void gla_scan(const KArgs& a, int tid, int G) {
    bf16* STb = (bf16*)(a.ws + WS_Y); const float* DCb = (const float*)(a.ws + WS_DC);
    for (int it = blockIdx.x; it < 256; it += G) {
        const int chain = it >> 1, half = it & 1, b = chain >> 3, h = (chain >> 1) & 3, d = chain & 1;
        const int e0 = half * 4096 + tid * 8, k0 = e0 & 63;
        f32x4 s0 = {0.f, 0.f, 0.f, 0.f}, s1 = {0.f, 0.f, 0.f, 0.f};
#define CID_OF(step) (((step) < 4) ? (1024 + b * 4 + (d ? 3 - (step) : (step))) : (b * 64 + (d ? (67 - (step)) : ((step) - 4))))
#define UB_OF(step) ((size_t)((CID_OF(step) * 4 + h) * 2 + d))
        u32x4v rd[8]; f32x4 rc0[8], rc1[8];
#pragma unroll
        for (int q = 0; q < 8; ++q) { const size_t ub = UB_OF(q); rd[q] = *(const u32x4v*)(STb + ub * 8192 + e0); rc0[q] = *(const f32x4*)(DCb + ub * 64 + k0); rc1[q] = *(const f32x4*)(DCb + ub * 64 + k0 + 4); }
#pragma unroll 1
        for (int sb = 0; sb < 68; sb += 8) {
#pragma unroll
            for (int q = 0; q < 8; ++q) { const int step = sb + q;
                if (step < 68) { const size_t ub = UB_OF(step); bf16* cur = STb + ub * 8192 + e0;
                    const u32x4v dr = rd[q]; const f32x4 c0 = rc0[q], c1 = rc1[q];
                    if (step + 8 < 68) { const size_t un = UB_OF(step + 8); rd[q] = *(const u32x4v*)(STb + un * 8192 + e0); rc0[q] = *(const f32x4*)(DCb + un * 64 + k0); rc1[q] = *(const f32x4*)(DCb + un * 64 + k0 + 4); }
                    u32x4v o; o.x = pk2(s0.x, s0.y); o.y = pk2(s0.z, s0.w); o.z = pk2(s1.x, s1.y); o.w = pk2(s1.z, s1.w); *(u32x4v*)cur = o;
                    const f32x4 d0 = {bflo(dr.x), bfhi(dr.x), bflo(dr.y), bfhi(dr.y)}, d1 = {bflo(dr.z), bfhi(dr.z), bflo(dr.w), bfhi(dr.w)};
                    s0 = c0 * s0 + d0; s1 = c1 * s1 + d1; } }
        }
#undef UB_OF
    }
}

__device__ __forceinline__ void gla_pass_c(const KArgs& a, int l, int cid, int h, unsigned char* lds, int tid, int lane, int wave) {
    const bf16* P = (const bf16*)(a.ws + WS_ACT); const int row0 = cid * 64, u = cid * 4 + h;
    const u32x4v qraw = *(const u32x4v*)(P + (size_t)(row0 + (tid >> 3)) * PSTR + PC_Q + h * 64 + (tid & 7) * 8), kraw = *(const u32x4v*)(P + (size_t)(row0 + (tid >> 3)) * PSTR + PC_K + h * 64 + (tid & 7) * 8);
    u32x4v vraw[2]; gla_load_v(P, row0, h, tid, vraw);
    u32x4v sraw[4];
    { const u32x4v* ST = (const u32x4v*)((const bf16*)(a.ws + WS_Y) + (size_t)(u * 2) * 8192);
#pragma unroll
      for (int rep = 0; rep < 4; ++rep) sraw[rep] = ST[tid + rep * NTHREADS]; }
    gla_gk(P, row0, h, a.in[I_WGK2] + (size_t)l * 2 * 16 * 256, a.in[I_BGK] + l * 2 * 256, lds, tid);
    const float* G = (const float*)(lds + GL_G); const float* TT = (const float*)(lds + GL_TT);
    bf16* QT = (bf16*)(lds + GL_QT); bf16* KA = (bf16*)(lds + GL_KA); bf16* SB = (bf16*)(lds + GL_SB); bf16* ATT = (bf16*)(lds + GL_ATT); float* SS = (float*)(lds + GL_SS);
    { const int tok = tid >> 3, kg = tid & 7; float qv[8], kv[8];
      unpack8(qraw, qv); unpack8(kraw, kv);
      float q0[8], k0[8], q1[8], k1[8];
#pragma unroll
      for (int q = 0; q < 8; ++q) { const int kc = kg * 8 + q; const float a0 = G[tok * 64 + kc], a1 = G[(64 + tok) * 64 + kc], tb = TT[64 + kc];
          q0[q] = qv[q] * 0.125f * __expf(a0); k0[q] = kv[q] * __expf(-a0); q1[q] = qv[q] * 0.125f * __expf(tb - a1); k1[q] = kv[q] * __expf(a1 - tb); }
      u32x4v o;
      o.x = pk2(q0[0], q0[1]); o.y = pk2(q0[2], q0[3]); o.z = pk2(q0[4], q0[5]); o.w = pk2(q0[6], q0[7]); *(u32x4v*)(QT + tok * RP + kg * 8) = o;
      o.x = pk2(q1[0], q1[1]); o.y = pk2(q1[2], q1[3]); o.z = pk2(q1[4], q1[5]); o.w = pk2(q1[6], q1[7]); *(u32x4v*)(QT + (64 + tok) * RP + kg * 8) = o;
      o.x = pk2(k0[0], k0[1]); o.y = pk2(k0[2], k0[3]); o.z = pk2(k0[4], k0[5]); o.w = pk2(k0[6], k0[7]); *(u32x4v*)(KA + tok * RP + kg * 8) = o;
      o.x = pk2(k1[0], k1[1]); o.y = pk2(k1[2], k1[3]); o.z = pk2(k1[4], k1[5]); o.w = pk2(k1[6], k1[7]); *(u32x4v*)(KA + (64 + tok) * RP + kg * 8) = o; }
    gla_store_vt(vraw, lds, tid);
#pragma unroll
    for (int rep = 0; rep < 4; ++rep) { const int idx = tid + rep * NTHREADS; *(u32x4v*)(SB + (idx >> 3) * RP + (idx & 7) * 8) = sraw[rep]; }
    __syncthreads();
    const int fr = lane & 15, fq = lane >> 4;
    {
        const int d = wave >> 2, ib = wave & 3; const bf16* QTd = QT + d * 64 * RP; const bf16* KAd = KA + d * 64 * RP; bf16* ATd = ATT + d * 64 * RP;
        const bf16x8 qa0 = FRAG(QTd, ib * 16, 0), qa1 = FRAG(QTd, ib * 16, 1);
#pragma unroll
        for (int jb = 0; jb < 4; ++jb) { f32x4 c = {0.f, 0.f, 0.f, 0.f};
            const bool live = d ? (jb >= ib) : (jb <= ib);
            if (live) { c = __builtin_amdgcn_mfma_f32_16x16x32_bf16(FRAG(KAd, jb * 16, 0), qa0, c, 0, 0, 0); c = __builtin_amdgcn_mfma_f32_16x16x32_bf16(FRAG(KAd, jb * 16, 1), qa1, c, 0, 0, 0); }
            const int i = ib * 16 + fr, j0 = jb * 16 + fq * 4;
#pragma unroll
            for (int r = 0; r < 4; ++r) { const int j = j0 + r; const bool keep = d ? (j >= i) : (j <= i); if (!keep) c[r] = 0.f; }
            u32x2v o; o.x = pk2(c[0], c[1]); o.y = pk2(c[2], c[3]); *(u32x2v*)(ATd + i * RP + j0) = o; }
    }
    __syncthreads();
    const int ib = wave & 3, vh = wave >> 2; const bf16* VT = (const bf16*)(lds + GL_VT);
    f32x4 acc[4];
#pragma unroll
    for (int vt = 0; vt < 4; ++vt) acc[vt] = (f32x4){0.f, 0.f, 0.f, 0.f};
#pragma unroll
    for (int d = 0; d < 2; ++d)
#pragma unroll
        for (int kk = 0; kk < 2; ++kk) { const bf16x8 fa = FRAG(ATT + d * 64 * RP, ib * 16, kk), fqv = FRAG(QT + d * 64 * RP, ib * 16, kk);
#pragma unroll
            for (int vt = 0; vt < 4; ++vt) { const int v0 = vh * 64 + vt * 16;
                acc[vt] = __builtin_amdgcn_mfma_f32_16x16x32_bf16(FRAGS(VT, v0, kk), fa, acc[vt], 0, 0, 0);
                acc[vt] = __builtin_amdgcn_mfma_f32_16x16x32_bf16(FRAG(SB + d * 128 * RP, v0, kk), fqv, acc[vt], 0, 0, 0); } }
    float ss = 0.f;
#pragma unroll
    for (int vt = 0; vt < 4; ++vt) ss += (acc[vt].x * acc[vt].x + acc[vt].y * acc[vt].y) + (acc[vt].z * acc[vt].z + acc[vt].w * acc[vt].w);
    ss += __shfl_xor(ss, 16); ss += __shfl_xor(ss, 32);
    if (fq == 0) SS[vh * 64 + ib * 16 + fr] = ss;
    __syncthreads();
    const int i = ib * 16 + fr; const float rs = rsqrtf((SS[i] + SS[64 + i]) * (1.0f / 128.0f) + EPS);
    const float* gg = a.in[I_GLAG] + l * 128; bf16* Z = (bf16*)(a.ws + WS_H);
#pragma unroll
    for (int vt = 0; vt < 4; ++vt) { const int v = vh * 64 + vt * 16 + fq * 4; const f32x4 gn = *(const f32x4*)(gg + v);
        const u32x2v graw = *(const u32x2v*)(P + (size_t)(row0 + i) * PSTR + PC_G + h * 128 + v);
        const float o0 = acc[vt].x * rs * gn.x * silu(bflo(graw.x)), o1 = acc[vt].y * rs * gn.y * silu(bfhi(graw.x)), o2 = acc[vt].z * rs * gn.z * silu(bflo(graw.y)), o3 = acc[vt].w * rs * gn.w * silu(bfhi(graw.y));
        u32x2v o; o.x = pk2(o0, o1); o.y = pk2(o2, o3); *(u32x2v*)(Z + (size_t)(row0 + i) * D + h * 128 + v) = o; }
    __syncthreads();
}

template <int W> __device__ __forceinline__ void pool_hsum(const float* V, const float* Us, bf16* zo, int ch, int tp, int pos0, int n) {
    constexpr int lo = W / 2, hi = W - 1 - lo;
#pragma unroll 4
    for (int tt = 0; tt < 32; ++tt) { const int tok = tp * 32 + tt, pos = pos0 + tok; float s = 0.f;
#pragma unroll
        for (int c = -lo; c <= hi; ++c) s += V[(8 + tok + c) * 256 + ch];
        const int cnt = min(pos + hi + 1, n) - max(pos - lo, 0);
        zo[(size_t)tok * D] = (bf16)f2bf(s / (float)cnt - Us[tok * 256 + ch]); }
}
__device__ __forceinline__ void pool_unit(const KArgs& a, bool grid, int b, int rs, unsigned char* lds, int tid) {
    const bf16* P = (const bf16*)(a.ws + WS_ACT); bf16* Z = (bf16*)(a.ws + WS_H); float* V = (float*)lds;
    float* U = (float*)(lds + 80 * 1024);
    int rowbase, pos0, n;
    if (grid) {
        rowbase = b * SEQ + rs * 64; pos0 = 0; n = 64;
        for (int e = tid; e < 16 * 256; e += NTHREADS) { const int rr = e >> 8; V[((rr < 8) ? rr : (64 + rr)) * 256 + (e & 255)] = 0.f; }
        const int tok = tid >> 3, c8 = (tid & 7) * 8; const bf16* pb = P + (size_t)(b * SEQ + tok) * PSTR + PC_POOL + c8;
#pragma unroll
        for (int gi = 0; gi < 4; ++gi) { const int w = 2 << gi, lo = w >> 1, hi = w - 1 - lo; float acc[8];
#pragma unroll
            for (int q = 0; q < 8; ++q) acc[q] = 0.f;
#pragma unroll
            for (int off = -lo; off <= hi; ++off) { const int rr = rs + off, rc = min(max(rr, 0), 63); const float msk = (rr == rc) ? 1.f : 0.f; float f[8];
                unpack8(*(const u32x4v*)(pb + (size_t)rc * 64 * PSTR + gi * 64), f);
#pragma unroll
                for (int q = 0; q < 8; ++q) acc[q] += f[q] * msk;
                if (off == 0) { float* ud = U + tok * 256 + gi * 64 + c8; *(f32x4*)ud = (f32x4){f[0], f[1], f[2], f[3]}; *(f32x4*)(ud + 4) = (f32x4){f[4], f[5], f[6], f[7]}; } }
            const float inv = 1.0f / (float)(min(rs + hi, 63) - max(rs - lo, 0) + 1);
            float* dst = V + (8 + tok) * 256 + gi * 64 + c8;
            *(f32x4*)dst = (f32x4){acc[0] * inv, acc[1] * inv, acc[2] * inv, acc[3] * inv}; *(f32x4*)(dst + 4) = (f32x4){acc[4] * inv, acc[5] * inv, acc[6] * inv, acc[7] * inv};
            if (gi == 1) asm volatile("" ::: "memory"); }
    } else {
        rowbase = TL + b * CTXL + rs * 64; pos0 = rs * 64; n = CTXL;
#pragma unroll
        for (int i = 0; i < 5; ++i) { const int e = tid + i * NTHREADS, tt = e >> 5, c8 = (e & 31) * 8, t = pos0 - 8 + tt, tc = min(max(t, 0), CTXL - 1); const float msk = (t == tc) ? 1.f : 0.f; float f[8];
            unpack8(*(const u32x4v*)(P + (size_t)(TL + b * CTXL + tc) * PSTR + PC_POOL + c8), f);
            float* dst = V + tt * 256 + c8; *(f32x4*)dst = (f32x4){f[0] * msk, f[1] * msk, f[2] * msk, f[3] * msk}; *(f32x4*)(dst + 4) = (f32x4){f[4] * msk, f[5] * msk, f[6] * msk, f[7] * msk}; }
    }
    __syncthreads();
    { const int ch = tid & 255, tp = tid >> 8, gi = __builtin_amdgcn_readfirstlane(ch >> 6); const float* Us = grid ? U : V + 8 * 256; bf16* zo = Z + (size_t)rowbase * D + 512 + ch;
      if (gi == 0) pool_hsum<2>(V, Us, zo, ch, tp, pos0, n); else if (gi == 1) pool_hsum<4>(V, Us, zo, ch, tp, pos0, n); else if (gi == 2) pool_hsum<8>(V, Us, zo, ch, tp, pos0, n); else pool_hsum<16>(V, Us, zo, ch, tp, pos0, n); }
    __syncthreads();
}

__device__ __forceinline__ void conv_unit(const KArgs& a, int l, int seqrow0, int t0, int n, unsigned char* lds, int tid, int lane, int wave) {
    const bf16* P = (const bf16*)(a.ws + WS_ACT); bf16* Z = (bf16*)(a.ws + WS_H);
    float* Hh = (float*)lds;
    float* CO = (float*)(lds + 94 * 1024);
#pragma unroll
    for (int i = 0; i < 6; ++i) { const int e = min(tid + i * NTHREADS, 94 * 32 - 1), tt = e >> 5, c8 = (e & 31) * 8, t = t0 - 15 + tt, tc = min(max(t, 0), n - 1); const float msk = (t == tc) ? 1.f : 0.f; float h[8], av[8], gv[8];
        const bf16* pr = P + (size_t)(seqrow0 + tc) * PSTR; unpack8(*(const u32x4v*)(pr + PC_CA + c8), av); unpack8(*(const u32x4v*)(pr + PC_CG + c8), gv);
#pragma unroll
        for (int q = 0; q < 8; ++q) h[q] = av[q] * sigmoid_f(gv[q]) * msk;
        float* dst = Hh + tt * 256 + c8; *(f32x4*)dst = (f32x4){h[0], h[1], h[2], h[3]}; *(f32x4*)(dst + 4) = (f32x4){h[4], h[5], h[6], h[7]}; }
    __syncthreads();
    { const int ch = tid & 255, half = tid >> 8; const float* dw = a.in[I_CDW] + (size_t)l * 31 * 256 + ch; float w[31];
#pragma unroll
      for (int j = 0; j < 31; ++j) w[j] = dw[j * 256];
      const float bias = a.in[I_CDWB][l * 256 + ch];
#pragma unroll 1
      for (int tb = 0; tb < 8; ++tb) { const int tok0 = half * 32 + tb * 4; float acc[4] = {bias, bias, bias, bias};
#pragma unroll
          for (int jj = 0; jj < 34; ++jj) { const float x = Hh[(tok0 + jj) * 256 + ch];
#pragma unroll
              for (int o = 0; o < 4; ++o) { const int j = jj - o; if (j >= 0 && j < 31) acc[o] += x * w[j]; } }
#pragma unroll
          for (int o = 0; o < 4; ++o) CO[(tok0 + o) * 256 + ch] = acc[o]; } }
    __syncthreads();
    { const f32x4 g = *(const f32x4*)(a.in[I_CLNG] + l * 256 + lane * 4), bb = *(const f32x4*)(a.in[I_CLNB] + l * 256 + lane * 4);
#pragma unroll
      for (int tt = 0; tt < 8; ++tt) { const int tok = wave + 8 * tt; const f32x4 x = *(const f32x4*)(CO + tok * 256 + lane * 4);
          const float mean = wave_sum((x.x + x.y) + (x.z + x.w)) * (1.0f / 256.0f); const f32x4 dlt = x - mean;
          const float var = wave_sum((dlt.x * dlt.x + dlt.y * dlt.y) + (dlt.z * dlt.z + dlt.w * dlt.w)) * (1.0f / 256.0f); const float rs = rsqrtf(var + EPS);
          const f32x4 y = dlt * rs * g + bb;
          u32x2v o; o.x = pk2(silu(y.x), silu(y.y)); o.y = pk2(silu(y.z), silu(y.w));
          *(u32x2v*)(Z + (size_t)(seqrow0 + t0 + tok) * D + 768 + lane * 4) = o; } }
    __syncthreads();
}

__global__ void __launch_bounds__(NTHREADS, 2) fwd_megakernel(KArgs kargs_unused) {
    extern __shared__ __attribute__((aligned(16))) unsigned char lds[];
    cg::grid_group grid = cg::this_grid();
    const int G = gridDim.x;
    volatile LAS unsigned* bst = (volatile LAS unsigned*)((LAS unsigned char*)lds + (LDS_BYTES - 16));
    if (threadIdx.x < 4) bst[threadIdx.x] = 0u;
    __syncthreads();
    XcdBarrier xbar; { const KArgs a0 = load_args(); xbar = xcd_barrier_post((unsigned*)(a0.ws + WS_BAR), bst); }
#define GRID_SYNC() xcd_barrier(xbar)
#ifndef NO_PREP
    { PHASE_LOCALS prep_phase(a, lds, tid, lane, wave, G); }
#endif
    if (G > 65535) grid.sync();
    GRID_SYNC();
    {
        PHASE_LOCALS
        const float* MODS = (const float*)(a.ws + WS_MODS);
        const NormP p{a.in[I_X], a.in[I_CTX], nullptr, nullptr, nullptr, 1, 0, nullptr, nullptr, 0.f, nullptr, 0, MODS + 0 * D, MODS + 1 * D, a.in[I_NORMG], (bf16*)(a.ws + WS_H), 1, TT_ROWS};
#ifndef NO_NORM
        norm_phase(p, lane, blockIdx.x * NWAVES + wave, G * NWAVES);
#endif
    }
    GRID_SYNC();
#pragma unroll 1
    for (int l = 0; l < 2; ++l) {
        const bool last = (l == 1);
#pragma unroll 1
        for (int sl = 0; sl < 3; ++sl) {
            const int Mrows = (last && sl == 2) ? TL : TT_ROWS;
            { const KArgs a = load_args(); const unsigned char* wl = a.ws + WS_W + (size_t)l * W_LAYER;
              pg8::Gemm g{(const bf16*)(a.ws + WS_H), (const bf16*)(wl + (sl == 0 ? WO_UP1 : (sl == 2 ? WO_UP2 : WO_IN))), Mrows, sl == 1 ? NIN : NUP, D};
              pg8::StaticOrder S; S.init(g.M, g.N, G, (int)blockIdx.x);
              pg8::EpiBf16 E{(bf16*)(a.ws + WS_ACT), sl == 1 ? NIN : DFF, sl == 1 ? 0 : 1, nullptr};
#ifndef NO_GEMM1
              pg8::gemm_phase<pg8::EpiBf16, pg8::StaticOrder, true, true>((PG8_LAS unsigned char*)lds, g, S, E);
#endif
            }
            GRID_SYNC();
            int M2 = Mrows;
            if (sl == 1) {
                M2 = last ? TL : TT_ROWS;
                const int nA = NCHUNK * 4, nPool = last ? 1024 : 1088, nConv = nPool;
#ifndef NO_PASSA
                { PHASE_LOCALS
#pragma unroll 1
                for (int it = blockIdx.x; it < nA; it += G) gla_pass_a(a, l, it >> 2, it & 3, lds, tid, lane, wave); }
#endif
#ifndef NO_POOLCONV
                { PHASE_LOCALS
#pragma unroll 1
                for (int j = ((G & 7) ? (int)blockIdx.x : (int)((blockIdx.x & 7) * (G >> 3) + (blockIdx.x >> 3))); j < nPool; j += G) { if (j < 1024) pool_unit(a, true, j >> 6, j & 63, lds, tid); else pool_unit(a, false, (j - 1024) >> 2, (j - 1024) & 3, lds, tid); } }
                { PHASE_LOCALS
#pragma unroll 1
                for (int j = (((G & 7) ? (int)blockIdx.x : (int)((blockIdx.x & 7) * (G >> 3) + (blockIdx.x >> 3))) + 128) % G; j < nConv; j += G) { if (j < 1024) conv_unit(a, l, (j >> 6) * SEQ, (j & 63) * 64, SEQ, lds, tid, lane, wave); else conv_unit(a, l, TL + ((j - 1024) >> 2) * CTXL, ((j - 1024) & 3) * 64, CTXL, lds, tid, lane, wave); } }
#endif
                GRID_SYNC();
#ifndef NO_SCAN
                { PHASE_LOCALS gla_scan(a, tid, G); }
#endif
                GRID_SYNC();
                const int nC = (last ? 1024 : NCHUNK) * 4;
#ifndef NO_PASSC
                { PHASE_LOCALS
#pragma unroll 1
                for (int it = blockIdx.x; it < nC; it += G) gla_pass_c(a, l, it >> 2, it & 3, lds, tid, lane, wave); }
#endif
                GRID_SYNC();
            }
            { const KArgs a = load_args(); const unsigned char* wl = a.ws + WS_W + (size_t)l * W_LAYER;
              pg8::Gemm g{(const bf16*)(a.ws + (sl == 1 ? WS_H : WS_ACT)), (const bf16*)(wl + (sl == 0 ? WO_DN1 : (sl == 2 ? WO_DN2 : WO_OUT))), M2, D, sl == 1 ? D : DFF};
              pg8::StaticOrder S; S.init(g.M, g.N, G, (int)blockIdx.x);
              pg8::EpiBf16 E{(bf16*)(a.ws + WS_Y), D, 0, sl == 1 ? (const float*)(a.ws + WS_BOUT) + l * D : nullptr};
#ifndef NO_GEMM2
              pg8::gemm_phase<pg8::EpiBf16, pg8::StaticOrder, true, true>((PG8_LAS unsigned char*)lds, g, S, E);
#endif
            }
            GRID_SYNC();
            { PHASE_LOCALS
              float* xlat = a.out; float* xctx = (float*)(a.ws + WS_CTXR); const float* MODS = (const float*)(a.ws + WS_MODS);
              const float* modl = MODS + (size_t)l * 17 * NMOD * D; const float* gains = a.in[I_NORMG] + (size_t)l * 6 * D;
              const bool first = (l == 0 && sl == 0), nxl = (sl == 2);
              const float* modn = nxl ? MODS + (size_t)(l + 1) * 17 * NMOD * D : modl + (3 * (sl + 1)) * D;
              const NormP p{a.in[I_X], a.in[I_CTX], xlat, xctx, (bf16*)(a.ws + WS_XR), first ? 1 : 0, (last && sl == 2) ? 1 : 0,
                            (const bf16*)(a.ws + WS_Y), modl + (3 * sl + 2) * D, (sl == 1) ? 1.0f : 0.5f, gains + (2 * sl + 1) * D, 1,
                            modn, modn + D, nxl ? a.in[I_NORMG] + (size_t)(l + 1) * 6 * D : gains + 2 * (sl + 1) * D, (bf16*)(a.ws + WS_H), !(last && sl == 2), M2};
#ifndef NO_NORM
              norm_phase(p, lane, blockIdx.x * NWAVES + wave, G * NWAVES);
#endif
            }
            if (!(last && sl == 2)) GRID_SYNC();
        }
    }
}

extern "C" void kernel_launch(void* const* d_in, const int* in_sizes, int n_in, void* d_out, int out_size, void* d_ws, size_t ws_size, hipStream_t stream) {
    static int grid_blocks = 0;
    if (grid_blocks == 0) {
        if (n_in != 24 || out_size != TL * D || ws_size < WS_END) { fprintf(stderr, "kernel_launch: unexpected shapes (n_in %d, out %d, ws %zu)\n", n_in, out_size, ws_size); grid_blocks = -1; return; }
        int dev = 0, cus = 0, per_cu = 0;
        hipGetDevice(&dev); hipDeviceGetAttribute(&cus, hipDeviceAttributeMultiprocessorCount, dev);
        if (hipFuncSetAttribute((const void*)fwd_megakernel, hipFuncAttributeMaxDynamicSharedMemorySize, LDS_BYTES) != hipSuccess) { fprintf(stderr, "kernel_launch: hipFuncSetAttribute failed\n"); grid_blocks = -1; return; }
        if (hipOccupancyMaxActiveBlocksPerMultiprocessor(&per_cu, (const void*)fwd_megakernel, NTHREADS, LDS_BYTES) != hipSuccess || per_cu < 1) { fprintf(stderr, "kernel_launch: occupancy query says %d\n", per_cu); per_cu = 1; }
        (void)hipGetLastError();
        grid_blocks = cus * per_cu;
    }
    if (grid_blocks < 0) return;
    if (hipMemsetAsync((char*)d_ws + WS_BAR, 0, BAR_BYTES, stream) != hipSuccess) { fprintf(stderr, "kernel_launch: memset of the barrier words failed\n"); return; }
    KArgs a{};
    for (int i = 0; i < 24; ++i) a.in[i] = (const float*)d_in[i];
    a.out = (float*)d_out; a.ws = (unsigned char*)d_ws;
    void* args[] = {&a};
    hipError_t e = hipLaunchCooperativeKernel((const void*)fwd_megakernel, dim3(grid_blocks), dim3(NTHREADS), args, LDS_BYTES, stream);
    if (e != hipSuccess) fprintf(stderr, "cooperative launch failed: %s (grid %d)\n", hipGetErrorString(e), grid_blocks);
}
```
